# Optimizing an MI355X kernel written in HIP

```python
import math
import jax, jax.numpy as jnp
from jax import lax
import numpy as np

D_MODEL = 1024
BATCH = 2
SEQ = 16384
DEPTH = 2

CTX_LEN = 256
GRID_W = 64
HEAD_DIM = 64
FOURIER_GROUPS = 6
FOURIER_WIDTH = FOURIER_GROUPS * HEAD_DIM
SWA_Q_HEADS = 8
SWA_KV_HEADS = 2
SWA_WIDTH = SWA_Q_HEADS * HEAD_DIM
WINDOW = 128
BLOCK = 128
CONV_WIDTH = 384
CONV_K = 3
DIFF_HEADS = 4
DIFF_V_DIM = 2 * HEAD_DIM
DIFF_WIDTH = DIFF_HEADS * DIFF_V_DIM
N_BRANCHES = 4
ROPE_BASE = 10000.0
NORM_EPS = 1e-6
NEG_INF = -1e30

IN_NAMES = ("a_x", "b_q", "b_k", "b_v", "c_x", "c_b", "c_c", "d_q", "d_k", "d_v",
            "z_a", "z_b", "z_c", "z_d", "m_g")
IN_SPLITS = (
    FOURIER_WIDTH,
    SWA_WIDTH, SWA_KV_HEADS * HEAD_DIM, SWA_KV_HEADS * HEAD_DIM,
    CONV_WIDTH, CONV_WIDTH, CONV_WIDTH,
    DIFF_HEADS * 2 * HEAD_DIM, DIFF_HEADS * 2 * HEAD_DIM, DIFF_WIDTH,
    FOURIER_WIDTH, SWA_WIDTH, CONV_WIDTH, DIFF_WIDTH,
    N_BRANCHES * D_MODEL,
)
IN_WIDTH = sum(IN_SPLITS)

kernel_name = "hybrid_fourier_swa_conv_diffattn_dit"


def rms_norm(t, gain):
    tf = t.astype(jnp.float32)
    y = tf * lax.rsqrt(jnp.mean(tf * tf, axis=-1, keepdims=True) + NORM_EPS)
    return (y * gain.astype(jnp.float32)).astype(t.dtype)


def rope_tables(n):
    rows = n // GRID_W
    row = jnp.broadcast_to(jnp.arange(rows, dtype=jnp.float32)[:, None], (rows, GRID_W)).reshape(-1)
    col = jnp.broadcast_to(jnp.arange(GRID_W, dtype=jnp.float32)[None, :], (rows, GRID_W)).reshape(-1)
    nf = HEAD_DIM // 4
    inv = ROPE_BASE ** (-jnp.arange(nf, dtype=jnp.float32) / nf)
    ar = row[:, None] * inv[None, :]
    ac = col[:, None] * inv[None, :]
    cos = jnp.concatenate([jnp.cos(ar), jnp.cos(ar), jnp.cos(ac), jnp.cos(ac)], axis=-1)
    sin = jnp.concatenate([jnp.sin(ar), jnp.sin(ar), jnp.sin(ac), jnp.sin(ac)], axis=-1)
    return cos, sin


def apply_rope(t, cos, sin):
    shape = (1, t.shape[1]) + (1,) * (t.ndim - 3) + (HEAD_DIM,)
    cs = cos.reshape(shape).astype(t.dtype)
    sn = sin.reshape(shape).astype(t.dtype)
    t1, t2, t3, t4 = jnp.split(t, 4, axis=-1)
    rot = jnp.concatenate([-t2, t1, -t4, t3], axis=-1)
    return t * cs + rot * sn


def in_project(h, w):
    idx = np.cumsum(np.array(IN_SPLITS))[:-1].tolist()
    parts = jnp.split(h @ w, idx, axis=-1)
    return dict(zip(IN_NAMES, parts))


def fourier_mix(u):
    b, n, _ = u.shape
    ug = u.astype(jnp.float32).reshape(b, n, FOURIER_GROUPS, HEAD_DIM)
    f = jnp.fft.fft2(ug, axes=(1, 3), norm="ortho").real
    return f.reshape(b, n, FOURIER_WIDTH).astype(u.dtype)


def short_conv(u_x, u_b, u_c, w):
    u = u_c * u_x
    n = u.shape[1]
    half = CONV_K // 2
    up = jnp.pad(u, ((0, 0), (half, half), (0, 0)))
    conv = sum(up[:, j:j + n] * w[j] for j in range(CONV_K))
    return u_b * conv


def window_attn_latent(q, k, v, kc, vc, sink):
    b, n, hq, d = q.shape
    hkv = k.shape[2]
    g = hq // hkv
    nb = n // BLOCK
    qb = q.reshape(b, nb, BLOCK, hkv, g, d)

    def band(t):
        tp = jnp.pad(t, ((0, 0), (BLOCK, BLOCK), (0, 0), (0, 0))).reshape(b, nb + 2, BLOCK, hkv, d)
        return jnp.concatenate([tp[:, :-2], tp[:, 1:-1], tp[:, 2:]], axis=2)

    kw, vw = band(k), band(v)
    qi = jnp.arange(BLOCK)[:, None]
    kj = jnp.arange(3 * BLOCK)[None, :]
    in_band = jnp.abs(kj - BLOCK - qi) <= WINDOW
    kpos = jnp.arange(nb)[:, None] * BLOCK + jnp.arange(3 * BLOCK)[None, :] - BLOCK
    valid = (kpos >= 0) & (kpos < n)
    mask = in_band[None] & valid[:, None, :]
    scale = HEAD_DIM ** -0.5
    s_loc = jnp.einsum("bnqhgd,bnkhd->bnhgqk", qb, kw).astype(jnp.float32) * scale
    s_loc = jnp.where(mask[None, :, None, None], s_loc, NEG_INF)
    s_ctx = jnp.einsum("bnqhgd,blhd->bnhgql", qb, kc).astype(jnp.float32) * scale
    sk = sink.astype(jnp.float32).reshape(1, 1, hkv, g, 1, 1)
    m = jnp.maximum(jnp.maximum(s_loc.max(-1, keepdims=True), s_ctx.max(-1, keepdims=True)), sk)
    p_loc = jnp.exp(s_loc - m)
    p_ctx = jnp.exp(s_ctx - m)
    inv = 1.0 / (p_loc.sum(-1, keepdims=True) + p_ctx.sum(-1, keepdims=True) + jnp.exp(sk - m))
    o = (jnp.einsum("bnhgqk,bnkhd->bnqhgd", (p_loc * inv).astype(v.dtype), vw)
         + jnp.einsum("bnhgql,blhd->bnqhgd", (p_ctx * inv).astype(v.dtype), vc))
    return o.reshape(b, n, hq * d)


def ctx_sink_attn(q, k, v, sink):
    b, l, hq, d = q.shape
    hkv = k.shape[2]
    g = hq // hkv
    qg = q.reshape(b, l, hkv, g, d)
    s = jnp.einsum("bqhgd,bkhd->bhgqk", qg, k).astype(jnp.float32) * (HEAD_DIM ** -0.5)
    sk = sink.astype(jnp.float32).reshape(1, hkv, g, 1, 1)
    m = jnp.maximum(s.max(-1, keepdims=True), sk)
    p = jnp.exp(s - m)
    p = p / (p.sum(-1, keepdims=True) + jnp.exp(sk - m))
    o = jnp.einsum("bhgqk,bkhd->bqhgd", p.astype(v.dtype), v)
    return o.reshape(b, l, hq * d)


def diff_attn_block(q, k, v, lam):
    s = jnp.einsum("bqhcd,bkhcd->bhcqk", q, k).astype(jnp.float32) * (HEAD_DIM ** -0.5)
    p = jax.nn.softmax(s, axis=-1)
    a = p[:, :, 0] - lam * p[:, :, 1]
    return jnp.einsum("bhqk,bkhe->bqhe", a.astype(v.dtype), v)


def diff_attn_latent(q, k, v, kc, vc, lam):
    b, n, h, _, d = q.shape
    nb = n // BLOCK
    k_all = jnp.concatenate([kc, k], axis=1)
    v_all = jnp.concatenate([vc, v], axis=1)
    qb = jnp.moveaxis(q.reshape(b, nb, BLOCK, h, 2, d), 1, 0)
    o = lax.map(lambda qq: diff_attn_block(qq, k_all, v_all, lam), qb)
    return jnp.moveaxis(o, 0, 1).reshape(b, n, h, DIFF_V_DIM)


def diff_out(o, subln_g, lam_init):
    b, n, h, e = o.shape
    return (rms_norm(o, subln_g) * (1.0 - lam_init)).reshape(b, n, h * e)


def merge(ys, zs, m_g, w_os, w_out_l):
    gates = jnp.split(jax.nn.sigmoid(m_g.astype(jnp.float32)).astype(m_g.dtype), N_BRANCHES, axis=-1)
    mixed = sum(gt * ((y * jax.nn.silu(z)) @ w) for gt, y, z, w in zip(gates, ys, zs, w_os))
    return mixed @ w_out_l


def setup_inputs(seed: int = 0) -> dict:
    key = jax.random.key(seed)
    ks = jax.random.split(key, 24)
    d = D_MODEL

    def nrm(k, shape, s):
        return jax.random.normal(k, shape, jnp.float32) * s

    return {
        "x": nrm(ks[0], (BATCH, SEQ, d), 1.0),
        "c": nrm(ks[1], (BATCH, d), 1.0),
        "ctx": nrm(ks[2], (BATCH, CTX_LEN, d), 1.0),
        "c_ctx": nrm(ks[3], (d,), 1.0),
        "norm_g": 1.0 + nrm(ks[4], (DEPTH, d), 0.02),
        "w_mod": nrm(ks[5], (DEPTH, d, 3 * d), 0.5 * d ** -0.5),
        "b_mod": nrm(ks[6], (DEPTH, 3 * d), 0.02),
        "w_in": nrm(ks[7], (DEPTH, d, IN_WIDTH), d ** -0.5),
        "q_norm_b": 1.0 + nrm(ks[8], (DEPTH, HEAD_DIM), 0.02),
        "k_norm_b": 1.0 + nrm(ks[9], (DEPTH, HEAD_DIM), 0.02),
        "sink_b": nrm(ks[10], (DEPTH, SWA_Q_HEADS), 0.5),
        "conv_w": nrm(ks[11], (DEPTH, CONV_K, CONV_WIDTH), CONV_K ** -0.5),
        "q_norm_d": 1.0 + nrm(ks[12], (DEPTH, HEAD_DIM), 0.02),
        "k_norm_d": 1.0 + nrm(ks[13], (DEPTH, HEAD_DIM), 0.02),
        "lam_q1": nrm(ks[14], (DEPTH, HEAD_DIM), 0.1),
        "lam_k1": nrm(ks[15], (DEPTH, HEAD_DIM), 0.1),
        "lam_q2": nrm(ks[16], (DEPTH, HEAD_DIM), 0.1),
        "lam_k2": nrm(ks[17], (DEPTH, HEAD_DIM), 0.1),
        "subln_d": 1.0 + nrm(ks[18], (DEPTH, DIFF_V_DIM), 0.02),
        "w_o_a": nrm(ks[19], (DEPTH, FOURIER_WIDTH, d), FOURIER_WIDTH ** -0.5),
        "w_o_b": nrm(ks[20], (DEPTH, SWA_WIDTH, d), SWA_WIDTH ** -0.5),
        "w_o_c": nrm(ks[21], (DEPTH, CONV_WIDTH, d), CONV_WIDTH ** -0.5),
        "w_o_d": nrm(ks[22], (DEPTH, DIFF_WIDTH, d), DIFF_WIDTH ** -0.5),
        "w_out": nrm(ks[23], (DEPTH, d, d), d ** -0.5),
    }


def reference(x, c, ctx, c_ctx, norm_g, w_mod, b_mod, w_in, q_norm_b, k_norm_b, sink_b, conv_w,
              q_norm_d, k_norm_d, lam_q1, lam_k1, lam_q2, lam_k2, subln_d,
              w_o_a, w_o_b, w_o_c, w_o_d, w_out):
    b, n, _ = x.shape
    lc = ctx.shape[1]
    cos, sin = rope_tables(n)
    for l in range(DEPTH):
        last = l == DEPTH - 1
        shift, scale, gate = jnp.split(jax.nn.silu(c) @ w_mod[l] + b_mod[l], 3, axis=-1)
        shift_c, scale_c, gate_c = jnp.split(jax.nn.silu(c_ctx) @ w_mod[l] + b_mod[l], 3, axis=-1)
        h = rms_norm(x, norm_g[l]) * (1.0 + scale[:, None]) + shift[:, None]
        hc = rms_norm(ctx, norm_g[l]) * (1.0 + scale_c) + shift_c
        p = in_project(h, w_in[l])
        pc = in_project(hc, w_in[l])

        lam_init = 0.8 - 0.6 * math.exp(-0.3 * l)
        lam = (jnp.exp(jnp.sum(lam_q1[l].astype(jnp.float32) * lam_k1[l].astype(jnp.float32)))
               - jnp.exp(jnp.sum(lam_q2[l].astype(jnp.float32) * lam_k2[l].astype(jnp.float32)))
               + lam_init)

        kc_b = rms_norm(pc["b_k"].reshape(b, lc, SWA_KV_HEADS, HEAD_DIM), k_norm_b[l])
        vc_b = pc["b_v"].reshape(b, lc, SWA_KV_HEADS, HEAD_DIM)
        kc_d = rms_norm(pc["d_k"].reshape(b, lc, DIFF_HEADS, 2, HEAD_DIM), k_norm_d[l])
        vc_d = pc["d_v"].reshape(b, lc, DIFF_HEADS, DIFF_V_DIM)

        y_a = fourier_mix(p["a_x"])
        q_b = apply_rope(rms_norm(p["b_q"].reshape(b, n, SWA_Q_HEADS, HEAD_DIM), q_norm_b[l]), cos, sin)
        k_b = apply_rope(rms_norm(p["b_k"].reshape(b, n, SWA_KV_HEADS, HEAD_DIM), k_norm_b[l]), cos, sin)
        v_b = p["b_v"].reshape(b, n, SWA_KV_HEADS, HEAD_DIM)
        y_b = window_attn_latent(q_b, k_b, v_b, kc_b, vc_b, sink_b[l])
        y_c = short_conv(p["c_x"], p["c_b"], p["c_c"], conv_w[l])
        q_d = apply_rope(rms_norm(p["d_q"].reshape(b, n, DIFF_HEADS, 2, HEAD_DIM), q_norm_d[l]), cos, sin)
        k_d = apply_rope(rms_norm(p["d_k"].reshape(b, n, DIFF_HEADS, 2, HEAD_DIM), k_norm_d[l]), cos, sin)
        v_d = p["d_v"].reshape(b, n, DIFF_HEADS, DIFF_V_DIM)
        y_d = diff_out(diff_attn_latent(q_d, k_d, v_d, kc_d, vc_d, lam), subln_d[l], lam_init)
        out = merge([y_a, y_b, y_c, y_d], [p["z_a"], p["z_b"], p["z_c"], p["z_d"]], p["m_g"],
                    [w_o_a[l], w_o_b[l], w_o_c[l], w_o_d[l]], w_out[l])
        x_next = x + gate[:, None] * out

        if not last:
            yc_a = fourier_mix(pc["a_x"])
            qc_b = rms_norm(pc["b_q"].reshape(b, lc, SWA_Q_HEADS, HEAD_DIM), q_norm_b[l])
            yc_b = ctx_sink_attn(qc_b, kc_b, vc_b, sink_b[l])
            yc_c = short_conv(pc["c_x"], pc["c_b"], pc["c_c"], conv_w[l])
            qc_d = rms_norm(pc["d_q"].reshape(b, lc, DIFF_HEADS, 2, HEAD_DIM), q_norm_d[l])
            yc_d = diff_out(diff_attn_block(qc_d, kc_d, vc_d, lam), subln_d[l], lam_init)
            out_c = merge([yc_a, yc_b, yc_c, yc_d], [pc["z_a"], pc["z_b"], pc["z_c"], pc["z_d"]], pc["m_g"],
                          [w_o_a[l], w_o_b[l], w_o_c[l], w_o_d[l]], w_out[l])
            ctx = ctx + gate_c * out_c
        x = x_next
    return x
```

```cpp
#include <hip/hip_runtime.h>
#include <hip/hip_cooperative_groups.h>
#include <stdint.h>
#include <stdio.h>
namespace cg = cooperative_groups;

typedef unsigned short bf16_t;
typedef short bf16x8 __attribute__((ext_vector_type(8)));
typedef float f32x2 __attribute__((ext_vector_type(2)));
typedef float f32x4 __attribute__((ext_vector_type(4)));
typedef float f32x16 __attribute__((ext_vector_type(16)));
typedef unsigned u32x2 __attribute__((ext_vector_type(2)));
typedef unsigned u32x4 __attribute__((ext_vector_type(4)));
typedef __bf16 bf16x2v __attribute__((ext_vector_type(2)));
#define LAS __attribute__((address_space(3)))
typedef LAS unsigned char lds8;
#define DI __device__ __forceinline__
#define MFMA32(a, b, c) __builtin_amdgcn_mfma_f32_32x32x16_bf16((a), (b), (c), 0, 0, 0)
#define MFMA16(a, b, c) __builtin_amdgcn_mfma_f32_16x16x32_bf16((a), (b), (c), 0, 0, 0)

constexpr int NT = 512;
constexpr int TT = 33280;
constexpr int TL = 32768;
constexpr int NKEY = 16640;
constexpr int LDPM = 3200, LDY = 1792;
constexpr int PM_AX = 0, PM_BQ = 384, PM_BK = 896, PM_CX = 1024, PM_CB = 1408, PM_CC = 1792, PM_DQ = 2176, PM_DK = 2688;
constexpr int Y_A = 0, Y_B = 384, Y_C = 896, Y_D = 1280;
constexpr size_t OFF_H = 0ull, OFF_PM = 68157440ull, OFF_Y = 281149440ull, OFF_WIN = 400424960ull, OFF_WO = 420347904ull,
                 OFF_WOUT = 424017920ull, OFF_AP = 428212224ull, OFF_VTD = 478543872ull, OFF_VTB = 512622592ull,
                 OFF_CTX1 = 521142272ull, OFF_MOD = 523239424ull, OFF_ROPE = 523313152ull, OFF_TAB = 523345920ull,
                 WS_END = 523526144ull;
constexpr size_t OFF_MIXED = OFF_AP;
constexpr size_t OFF_SCR = OFF_PM;
constexpr int LDS_BYTES = 143360;
constexpr float QSCALE = 0.18033688011112042f;
constexpr float LOG2E = 1.4426950408889634f;

struct Params {
  const float *x, *c, *ctx, *c_ctx, *norm_g, *w_mod, *b_mod, *w_in, *q_norm_b, *k_norm_b, *sink_b, *conv_w,
              *q_norm_d, *k_norm_d, *lam_q1, *lam_k1, *lam_q2, *lam_k2, *subln_d, *w_o_a, *w_o_b, *w_o_c, *w_o_d, *w_out;
  float* out; unsigned char* ws;
};

DI int launder_tid() { int t = threadIdx.x; asm volatile("" : "+v"(t)); return t; }
DI unsigned pk2(float lo, float hi) { f32x2 v = {lo, hi}; return __builtin_bit_cast(unsigned, __builtin_convertvector(v, bf16x2v)); }
DI bf16_t f2bf(float x) { return (bf16_t)(pk2(x, 0.f) & 0xffffu); }
DI float bf2f(bf16_t u) { return __uint_as_float(((unsigned)u) << 16); }
DI float bflo(unsigned u) { return __uint_as_float(u << 16); }
DI float bfhi(unsigned u) { return __uint_as_float(u & 0xffff0000u); }
DI float siluf(float x) { return x / (1.f + __expf(-x)); }
DI float sigm(float x) { return 1.f / (1.f + __expf(-x)); }
DI int crow(int i, int h) { return (i & 3) + 8 * (i >> 2) + 4 * h; }
DI float cosrev(float r) { return __builtin_amdgcn_cosf(r); }
DI float sinrev(float r) { return __builtin_amdgcn_sinf(r); }
DI bf16x8 pack8(const f32x16& v, int s) {
  u32x4 w;
  w.x = pk2(v[8 * s + 0], v[8 * s + 1]); w.y = pk2(v[8 * s + 2], v[8 * s + 3]);
  w.z = pk2(v[8 * s + 4], v[8 * s + 5]); w.w = pk2(v[8 * s + 6], v[8 * s + 7]);
  return __builtin_bit_cast(bf16x8, w);
}
DI f32x16 splat16(float x) { f32x16 v; _Pragma("unroll") for (int i = 0; i < 16; ++i) v[i] = x; return v; }

DI void tconv_tile(const float* __restrict__ src, int N, bf16_t* __restrict__ dst, int K, int tk, int tn, LAS float* sm) {
  const int t = launder_tid();
#pragma unroll
  for (int i = 0; i < 8; ++i) { const int e = t + i * NT, r = e >> 6, c = e & 63; sm[r * 65 + c] = src[(size_t)(tk * 64 + r) * N + tn * 64 + c]; }
  __syncthreads();
  { const int n = t >> 3, kc = t & 7; u32x4 w;
    w.x = pk2(sm[(kc * 8 + 0) * 65 + n], sm[(kc * 8 + 1) * 65 + n]); w.y = pk2(sm[(kc * 8 + 2) * 65 + n], sm[(kc * 8 + 3) * 65 + n]);
    w.z = pk2(sm[(kc * 8 + 4) * 65 + n], sm[(kc * 8 + 5) * 65 + n]); w.w = pk2(sm[(kc * 8 + 6) * 65 + n], sm[(kc * 8 + 7) * 65 + n]);
    *(u32x4*)(dst + (size_t)(tn * 64 + n) * K + tk * 64 + kc * 8) = w; }
  __syncthreads();
}

DI void prep_item(const Params& p, int l, int it, lds8* lds) {
  bf16_t* WIN = (bf16_t*)(p.ws + OFF_WIN); bf16_t* WO = (bf16_t*)(p.ws + OFF_WO); bf16_t* WOUT = (bf16_t*)(p.ws + OFF_WOUT);
  const float* src; bf16_t* dst; int K, N, ti;
  if (it < 2432) { src = p.w_in + (size_t)l * 1024 * 9728; dst = WIN; K = 1024; N = 9728; ti = it; }
  else if (it < 2528) { src = p.w_o_a + (size_t)l * 384 * 1024; dst = WO; K = 384; N = 1024; ti = it - 2432; }
  else if (it < 2656) { src = p.w_o_b + (size_t)l * 512 * 1024; dst = WO + 393216; K = 512; N = 1024; ti = it - 2528; }
  else if (it < 2752) { src = p.w_o_c + (size_t)l * 384 * 1024; dst = WO + 917504; K = 384; N = 1024; ti = it - 2656; }
  else if (it < 2880) { src = p.w_o_d + (size_t)l * 512 * 1024; dst = WO + 1310720; K = 512; N = 1024; ti = it - 2752; }
  else { src = p.w_out + (size_t)l * 1024 * 1024; dst = WOUT + (size_t)l * 1048576; K = 1024; N = 1024; ti = it - 2880; }
  const int ntk = K / 64; const int tk = ti % ntk, tn = ti / ntk;
  tconv_tile(src, N, dst, K, tk, tn, (LAS float*)lds);
}
constexpr int PREP_ITEMS = 3136;

DI void mod_item(const Params& p, int mi, lds8* lds) {
  const int l2 = mi / 48, jc = mi % 48, tid = threadIdx.x;
  LAS float* ssil = (LAS float*)lds; LAS float* part = ssil + 3072;
  for (int e = tid; e < 3072; e += NT) { const int v = e >> 10, k = e & 1023; const float cv = v < 2 ? p.c[v * 1024 + k] : p.c_ctx[k]; ssil[e] = siluf(cv); }
  __syncthreads();
  const int col = tid & 63, ks = tid >> 6; const int j = jc * 64 + col;
  float a0 = 0.f, a1 = 0.f, a2 = 0.f; const float* w = p.w_mod + (size_t)l2 * 1024 * 3072 + j;
  for (int k = ks * 128; k < ks * 128 + 128; ++k) { const float wv = w[(size_t)k * 3072]; a0 += ssil[k] * wv; a1 += ssil[1024 + k] * wv; a2 += ssil[2048 + k] * wv; }
  part[(ks * 3 + 0) * 64 + col] = a0; part[(ks * 3 + 1) * 64 + col] = a1; part[(ks * 3 + 2) * 64 + col] = a2;
  __syncthreads();
  if (tid < 192) { const int v = tid >> 6, cc = tid & 63; float s = 0.f;
    for (int q = 0; q < 8; ++q) s += part[(q * 3 + v) * 64 + cc];
    float* MOD = (float*)(p.ws + OFF_MOD); MOD[(l2 * 3 + v) * 3072 + jc * 64 + cc] = s + p.b_mod[l2 * 3072 + jc * 64 + cc]; }
  __syncthreads();
}

DI void tables_item(const Params& p, int which) {
  const int tid = launder_tid();
  if (which == 0) {
    float* RT = (float*)(p.ws + OFF_ROPE);
    for (int e = tid; e < 4096; e += NT) { const int pos = e >> 4, i = e & 15;
      const float inv = exp2f(-(float)i * (13.287712379549449f / 16.f)); const float ang = (float)pos * inv;
      float rev = ang * 0.15915494309189535f; rev -= floorf(rev);
      RT[2 * e] = cosrev(rev); RT[2 * e + 1] = sinrev(rev); }
  } else {
    bf16_t* WcT = (bf16_t*)(p.ws + OFF_TAB); bf16_t* CP = WcT + 8192; bf16_t* SP = CP + 16384; bf16_t* NSP = SP + 16384; bf16_t* CN = NSP + 16384; bf16_t* SN = CN + 16384;
    for (int e = tid; e < 16384; e += NT) { const int k = e >> 7, pos = e & 127;
      const int tn = (k * pos) & 127; const float rn = (float)tn * (1.f / 128.f);
      CN[e] = f2bf(cosrev(rn)); SN[e] = f2bf(sinrev(rn));
      const int j = pos & 7, h = (pos >> 3) & 1, s = (pos >> 4) & 1, rb = pos >> 5; const int n1 = 32 * rb + 16 * s + 8 * (j >> 2) + 4 * h + (j & 3);
      const int tp = (k * n1) & 127; const float rp = (float)tp * (1.f / 128.f); const float cs = cosrev(rp), sn = sinrev(rp);
      CP[e] = f2bf(cs); SP[e] = f2bf(sn); NSP[e] = f2bf(-sn); }
    for (int e = tid; e < 8192; e += NT) { const int mp = e >> 6, c = e & 63; const int m = mp & 63; const int t = (m * c) & 63; const float rr = (float)t * (1.f / 64.f);
      WcT[e] = f2bf(mp < 64 ? cosrev(rr) : -sinrev(rr)); }
  }
}

DI void phase_norm(const Params& p, int l) {
  const int tid = launder_tid(), lane = tid & 63, w = tid >> 6;
  bf16_t* H = (bf16_t*)(p.ws + OFF_H); const float* MOD = (const float*)(p.ws + OFF_MOD);
  const float* xl = l == 0 ? p.x : p.out; const float* xc = l == 0 ? p.ctx : (const float*)(p.ws + OFF_CTX1);
  const float* ng = p.norm_g + l * 1024;
  for (int R = blockIdx.x * 8 + w; R < TT; R += gridDim.x * 8) {
    const float* src; int v;
    if (R < TL) { src = xl + (size_t)R * 1024; v = R >> 14; } else { src = xc + (size_t)(R - TL) * 1024; v = 2; }
    const float* md = MOD + (l * 3 + v) * 3072;
    f32x4 xv[4]; float ss = 0.f;
#pragma unroll
    for (int i = 0; i < 4; ++i) { xv[i] = *(const f32x4*)(src + (lane + 64 * i) * 4); ss += xv[i][0] * xv[i][0] + xv[i][1] * xv[i][1] + xv[i][2] * xv[i][2] + xv[i][3] * xv[i][3]; }
#pragma unroll
    for (int o = 32; o >= 1; o >>= 1) ss += __shfl_xor(ss, o);
    const float rs = rsqrtf(ss * (1.f / 1024.f) + 1e-6f);
#pragma unroll
    for (int i = 0; i < 4; ++i) { const int col = (lane + 64 * i) * 4;
      const f32x4 g = *(const f32x4*)(ng + col), sh = *(const f32x4*)(md + col), sc = *(const f32x4*)(md + 1024 + col);
      float h0 = xv[i][0] * rs * g[0] * (1.f + sc[0]) + sh[0], h1 = xv[i][1] * rs * g[1] * (1.f + sc[1]) + sh[1];
      float h2 = xv[i][2] * rs * g[2] * (1.f + sc[2]) + sh[2], h3 = xv[i][3] * rs * g[3] * (1.f + sc[3]) + sh[3];
      u32x2 o; o.x = pk2(h0, h1); o.y = pk2(h2, h3); *(u32x2*)(H + (size_t)R * 1024 + col) = o; }
  }
}

namespace g8 {
constexpr int BK = 64, HALF = 128, HTB = HALF * BK * 2;
DI int lds_byte(int r, int c) { const int st = (r >> 4) * 2 + (c >> 5), rr = r & 15, cc = c & 31, ob = rr * 64 + cc * 2; return st * 1024 + (ob ^ (((ob >> 9) & 1) << 5)); }
DI void stage_rc(int b, int& R, int& C) { const int st = b / 1024, sb = b % 1024, swz = sb ^ (((sb >> 9) & 1) << 5); R = (st >> 1) * 16 + swz / 64; C = (st & 1) * 32 + (swz % 64) / 2; }

#define G8_SA(b, h) (((b) * 2 + (h)) * HTB)
#define G8_SB(b, h) ((4 + (b) * 2 + (h)) * HTB)
#define G8_STAGE(bufoff, gbase, ld, voff, row0, kt) do { _Pragma("unroll") for (int _i = 0; _i < 2; ++_i) \
    __builtin_amdgcn_global_load_lds((const unsigned*)((gbase) + (size_t)(row0) * (ld) + (size_t)(kt) * BK + (voff)[_i]), (LAS unsigned*)(lds + (bufoff) + tid * 16 + _i * 8192), 16, 0, 0); } while (0)
#define G8_STA(bufoff, half, kt) G8_STAGE(bufoff, A, lda, voffA, brow + (half) * HALF, kt)
#define G8_STB(bufoff, half, kt) G8_STAGE(bufoff, Bt, ldb, voffB, bcol + (half) * HALF, kt)
#define G8_LDA(dst, b, h) do { _Pragma("unroll") for (int m = 0; m < 4; ++m) _Pragma("unroll") for (int k = 0; k < 2; ++k) dst[m][k] = *(const LAS bf16x8*)(lds + G8_SA(b, h) + aoff + m * 2048 + k * 1024); } while (0)
#define G8_LDB(dst, b, h) do { _Pragma("unroll") for (int n = 0; n < 2; ++n) _Pragma("unroll") for (int k = 0; k < 2; ++k) dst[n][k] = *(const LAS bf16x8*)(lds + G8_SB(b, h) + boff + n * 2048 + k * 1024); } while (0)
#define G8_MMA(ai, bj, At_, Bt_) do { __builtin_amdgcn_s_setprio(1); _Pragma("unroll") for (int m = 0; m < 4; ++m) _Pragma("unroll") for (int n = 0; n < 2; ++n) _Pragma("unroll") for (int k = 0; k < 2; ++k) \
    acc[ai][bj][m][n] = MFMA16(Bt_[n][k], At_[m][k], acc[ai][bj][m][n]); __builtin_amdgcn_s_setprio(0); } while (0)
#define G8_WAIT_V(n) asm volatile("s_waitcnt vmcnt(" #n ")" ::: "memory")
#define G8_WAIT_L(n) asm volatile("s_waitcnt lgkmcnt(" #n ")" ::: "memory")
#define G8_BAR __builtin_amdgcn_s_barrier()
#define G8_SCHED __builtin_amdgcn_sched_barrier(0)

template <int lda, int ldb, int K>
DI void gemm_tile(lds8* lds, const bf16_t* __restrict__ A, const bf16_t* __restrict__ Bt, int brow, int bcol, f32x4 (&acc)[2][2][4][2]) {
  const int tid = launder_tid(), wid = tid >> 6, lane = tid & 63, wr = wid >> 2, wc = wid & 3, fr = lane & 15, fq = lane >> 4;
  unsigned voffA[2], voffB[2];
#pragma unroll
  for (int i = 0; i < 2; ++i) { int R, C; stage_rc(tid * 16 + i * 8192, R, C); voffA[i] = (unsigned)(R * lda + C); voffB[i] = (unsigned)(R * ldb + C); }
  const int aoff = lds_byte(wr * 64 + fr, fq * 8), boff = lds_byte(wc * 32 + fr, fq * 8);
#pragma unroll
  for (int a = 0; a < 2; ++a)
#pragma unroll
    for (int b = 0; b < 2; ++b)
#pragma unroll
      for (int m = 0; m < 4; ++m)
#pragma unroll
        for (int n = 0; n < 2; ++n) acc[a][b][m][n] = (f32x4){0.f, 0.f, 0.f, 0.f};
  bf16x8 At[4][2], B0[2][2], B1[2][2];
  constexpr int nt = K / BK;
  G8_STB(G8_SB(0, 0), 0, 0); G8_STA(G8_SA(0, 0), 0, 0);
  G8_STB(G8_SB(0, 1), 1, 0); G8_STA(G8_SA(0, 1), 1, 0);
  if (wr == 1) G8_BAR;
  G8_WAIT_V(4); G8_BAR;
  G8_STB(G8_SB(1, 0), 0, 1); G8_STA(G8_SA(1, 0), 0, 1); G8_STB(G8_SB(1, 1), 1, 1);
  G8_WAIT_V(6); G8_BAR;
  for (int t = 0; t < nt - 2; t += 2) {
    G8_LDB(B0, 0, 0); G8_SCHED; G8_LDA(At, 0, 0); G8_STA(G8_SA(1, 1), 1, t + 1);
    G8_WAIT_L(8); G8_BAR; G8_WAIT_L(0); G8_MMA(0, 0, At, B0); G8_BAR; G8_SCHED;
    G8_LDB(B1, 0, 1); G8_STB(G8_SB(0, 0), 0, t + 2);
    G8_BAR; G8_WAIT_L(0); G8_MMA(0, 1, At, B1); G8_BAR;
    G8_LDA(At, 0, 1); G8_STA(G8_SA(0, 0), 0, t + 2);
    G8_BAR; G8_WAIT_L(0); G8_MMA(1, 0, At, B0); G8_BAR; G8_SCHED;
    G8_STB(G8_SB(0, 1), 1, t + 2);
    G8_WAIT_V(6); G8_BAR; G8_MMA(1, 1, At, B1); G8_BAR;
    G8_LDB(B0, 1, 0); G8_SCHED; G8_LDA(At, 1, 0); G8_STA(G8_SA(0, 1), 1, t + 2);
    G8_WAIT_L(8); G8_BAR; G8_WAIT_L(0); G8_MMA(0, 0, At, B0); G8_BAR; G8_SCHED;
    G8_LDB(B1, 1, 1); G8_STB(G8_SB(1, 0), 0, t + 3);
    G8_BAR; G8_WAIT_L(0); G8_MMA(0, 1, At, B1); G8_BAR;
    G8_LDA(At, 1, 1); G8_STA(G8_SA(1, 0), 0, t + 3);
    G8_BAR; G8_WAIT_L(0); G8_MMA(1, 0, At, B0); G8_BAR; G8_SCHED;
    G8_STB(G8_SB(1, 1), 1, t + 3);
    G8_WAIT_V(6); G8_BAR; G8_MMA(1, 1, At, B1); G8_BAR;
  }
  { G8_LDB(B0, 0, 0); G8_LDA(At, 0, 0); G8_STA(G8_SA(1, 1), 1, nt - 1);
    G8_BAR; G8_WAIT_L(0); G8_MMA(0, 0, At, B0); G8_BAR;
    G8_LDB(B1, 0, 1); G8_BAR; G8_WAIT_L(0); G8_MMA(0, 1, At, B1); G8_BAR;
    G8_LDA(At, 0, 1); G8_WAIT_V(4); G8_BAR; G8_WAIT_L(0); G8_MMA(1, 0, At, B0); G8_MMA(1, 1, At, B1); G8_BAR; }
  { G8_LDB(B0, 1, 0); G8_LDA(At, 1, 0); G8_WAIT_V(2); G8_BAR; G8_WAIT_L(0); G8_MMA(0, 0, At, B0); G8_BAR;
    G8_LDB(B1, 1, 1); G8_WAIT_V(0); G8_BAR; G8_WAIT_L(0); G8_MMA(0, 1, At, B1); G8_BAR;
    G8_LDA(At, 1, 1); G8_BAR; G8_WAIT_L(0); G8_MMA(1, 0, At, B0); G8_MMA(1, 1, At, B1); G8_BAR; }
  if (wr == 0) G8_BAR;
  __syncthreads();
}
}

DI bool unit_next(int nM, int nN, int L, int& pm, int& pn) {
  const int nwg = nM * nN; if (L >= nwg) return false;
  int wgid = L; { const int q = nwg / 8, r = nwg % 8, xcd = wgid % 8, off = wgid / 8; wgid = (xcd < r ? xcd * (q + 1) : r * (q + 1) + (xcd - r) * q) + off; }
  const int nig = 8 * nN, gid = wgid / nig, fm = gid * 8, gsz = (nM - fm) < 8 ? (nM - fm) : 8;
  pm = fm + ((wgid % nig) % gsz); pn = (wgid % nig) / gsz; return true;
}

DI void phase_inproj(const Params& p, lds8* lds) {
  const int tid = launder_tid(), wid = tid >> 6, lane = tid & 63, wr = wid >> 2, wc = wid & 3, fr = lane & 15, fq = lane >> 4;
  const bf16_t* H = (const bf16_t*)(p.ws + OFF_H); const bf16_t* WIN = (const bf16_t*)(p.ws + OFF_WIN);
  bf16_t* PM = (bf16_t*)(p.ws + OFF_PM); bf16_t* Y = (bf16_t*)(p.ws + OFF_Y); bf16_t* VTD = (bf16_t*)(p.ws + OFF_VTD); bf16_t* VTB = (bf16_t*)(p.ws + OFF_VTB);
  for (int i = 0;; ++i) {
    int pm, pn; if (!unit_next(130, 22, i * gridDim.x + blockIdx.x, pm, pn)) break;
    f32x4 acc[2][2][4][2];
    g8::gemm_tile<1024, 1024, 1024>(lds, H, WIN, pm * 256, pn * 256, acc);
#pragma unroll
    for (int bj = 0; bj < 2; ++bj) {
      const int colh = pn * 256 + bj * 128;
      int mode, dcol, ld; bf16_t* dst;
      if (colh < 1024) { mode = 0; dst = PM; ld = LDPM; dcol = colh; }
      else if (colh < 1152) { mode = 1; dst = VTB; ld = 128; dcol = colh - 1024; }
      else if (colh < 3328) { mode = 0; dst = PM; ld = LDPM; dcol = colh - 128; }
      else if (colh < 3840) { mode = 1; dst = VTD; ld = 512; dcol = colh - 3328; }
      else { mode = 2; dst = Y; ld = LDY; dcol = colh - 3840; }
#pragma unroll
      for (int ai = 0; ai < 2; ++ai)
#pragma unroll
        for (int m = 0; m < 4; ++m) {
          const int row = pm * 256 + ai * 128 + wr * 64 + m * 16 + fr;
#pragma unroll
          for (int n = 0; n < 2; ++n) {
            const int c4 = dcol + wc * 32 + n * 16 + fq * 4; f32x4 v = acc[ai][bj][m][n];
            if (mode == 1) {
              int b, key; if (row < TL) { b = row >> 14; key = 256 + (row & 16383); } else { b = (row - TL) >> 8; key = (row - TL) & 255; }
#pragma unroll
              for (int j = 0; j < 4; ++j) dst[((size_t)(b * ld + c4 + j)) * NKEY + key] = f2bf(v[j]);
            } else {
              if (mode == 2) { v[0] = siluf(v[0]); v[1] = siluf(v[1]); v[2] = siluf(v[2]); v[3] = siluf(v[3]); }
              u32x2 o; o.x = pk2(v[0], v[1]); o.y = pk2(v[2], v[3]); *(u32x2*)(dst + (size_t)row * ld + c4) = o;
            }
          }
        }
    }
  }
}

DI void normrope_item(const Params& p, int l, int item, int lane) {
  bf16_t* PM = (bf16_t*)(p.ws + OFF_PM); const float* RT = (const float*)(p.ws + OFF_ROPE);
  const int R = item >> 2, gi = item & 3;
  int col0, ncol; const float* gain; float scale;
  if (gi == 0) { col0 = PM_BQ; ncol = 512; gain = p.q_norm_b + l * 64; scale = QSCALE; }
  else if (gi == 1) { col0 = PM_DQ; ncol = 512; gain = p.q_norm_d + l * 64; scale = QSCALE; }
  else if (gi == 2) { col0 = PM_DK; ncol = 512; gain = p.k_norm_d + l * 64; scale = 1.f; }
  else { col0 = PM_BK; ncol = 128; gain = p.k_norm_b + l * 64; scale = 1.f; }
  const bool act = lane * 8 < ncol;
  bf16_t* ptr = PM + (size_t)R * LDPM + col0 + lane * 8;
  u32x4 raw = {0u, 0u, 0u, 0u}; if (act) raw = *(const u32x4*)ptr;
  float y[8]; y[0] = bflo(raw.x); y[1] = bfhi(raw.x); y[2] = bflo(raw.y); y[3] = bfhi(raw.y); y[4] = bflo(raw.z); y[5] = bfhi(raw.z); y[6] = bflo(raw.w); y[7] = bfhi(raw.w);
  float ss = 0.f;
#pragma unroll
  for (int e = 0; e < 8; ++e) ss += y[e] * y[e];
  ss += __shfl_xor(ss, 1); ss += __shfl_xor(ss, 2); ss += __shfl_xor(ss, 4);
  const float rs = rsqrtf(ss * (1.f / 64.f) + 1e-6f);
  const int l8 = lane & 7;
#pragma unroll
  for (int e = 0; e < 8; ++e) y[e] = y[e] * rs * gain[l8 * 8 + e];
  const bool rope = R < TL;
  if (rope) {
    const int n = R & 16383, prow = n >> 6, pcol = n & 63; const int quarter = l8 >> 1; const int pos = quarter < 2 ? prow : pcol;
    const float sgn = (quarter & 1) ? 1.f : -1.f;
#pragma unroll
    for (int e = 0; e < 8; ++e) { const float yp = __shfl_xor(y[e], 2); const int i = 8 * (l8 & 1) + e; const f32x2 cs = *(const f32x2*)(RT + 2 * (pos * 16 + i)); y[e] = y[e] * cs.x + sgn * yp * cs.y; }
  }
  if (act) { u32x4 o; o.x = pk2(y[0] * scale, y[1] * scale); o.y = pk2(y[2] * scale, y[3] * scale); o.z = pk2(y[4] * scale, y[5] * scale); o.w = pk2(y[6] * scale, y[7] * scale); *(u32x4*)ptr = o; }
}

DI void unpack8(const u32x4& r, float (&y)[8]) { y[0] = bflo(r.x); y[1] = bfhi(r.x); y[2] = bflo(r.y); y[3] = bfhi(r.y); y[4] = bflo(r.z); y[5] = bfhi(r.z); y[6] = bflo(r.w); y[7] = bfhi(r.w); }

DI void conv_item(const Params& p, int l, int item) {
  const bf16_t* PM = (const bf16_t*)(p.ws + OFF_PM); bf16_t* Y = (bf16_t*)(p.ws + OFF_Y);
  const int R = item / 48, ch = (item % 48) * 8;
  int n, N; if (R < TL) { n = R & 16383; N = 16384; } else { n = (R - TL) & 255; N = 256; }
  const float* cw = p.conv_w + l * 3 * 384 + ch;
  float conv[8];
#pragma unroll
  for (int e = 0; e < 8; ++e) conv[e] = 0.f;
#pragma unroll
  for (int j = 0; j < 3; ++j) { const int nn = n + j - 1; if (nn >= 0 && nn < N) {
      const size_t rr = (size_t)(R + j - 1) * LDPM; float xa[8], ca[8]; unpack8(*(const u32x4*)(PM + rr + PM_CX + ch), xa); unpack8(*(const u32x4*)(PM + rr + PM_CC + ch), ca);
#pragma unroll
      for (int e = 0; e < 8; ++e) conv[e] += cw[j * 384 + e] * (xa[e] * ca[e]); } }
  float ba[8], sz[8]; unpack8(*(const u32x4*)(PM + (size_t)R * LDPM + PM_CB + ch), ba);
  bf16_t* yp = Y + (size_t)R * LDY + Y_C + ch; unpack8(*(const u32x4*)yp, sz);
  u32x4 o; o.x = pk2(ba[0] * conv[0] * sz[0], ba[1] * conv[1] * sz[1]); o.y = pk2(ba[2] * conv[2] * sz[2], ba[3] * conv[3] * sz[3]);
  o.z = pk2(ba[4] * conv[4] * sz[4], ba[5] * conv[5] * sz[5]); o.w = pk2(ba[6] * conv[6] * sz[6], ba[7] * conv[7] * sz[7]); *(u32x4*)yp = o;
}

DI void fourierA_item(const Params& p, int b, int n2, int g) {
  const int tid = launder_tid(), lane = tid & 63, w = tid >> 6, r = lane & 31, hh = lane >> 5, mb = w & 1, kq = w >> 1;
  const bf16_t* PM = (const bf16_t*)(p.ws + OFF_PM); const bf16_t* WcT = (const bf16_t*)(p.ws + OFF_TAB);
  const bf16_t* CP = WcT + 8192; const bf16_t* SP = CP + 16384; const bf16_t* NSP = SP + 16384; bf16_t* AP = (bf16_t*)(p.ws + OFF_AP);
  bf16x8 wfr[2][4];
#pragma unroll
  for (int part = 0; part < 2; ++part)
#pragma unroll
    for (int s = 0; s < 4; ++s) wfr[part][s] = *(const bf16x8*)(WcT + (64 * part + 32 * mb + r) * 64 + 16 * s + 8 * hh);
  bf16x8 vf[4][2][2];
#pragma unroll
  for (int rb = 0; rb < 4; ++rb) {
    const size_t token = (size_t)b * 16384 + 128 * (32 * rb + r) + n2; bf16x8 uf[4];
#pragma unroll
    for (int s = 0; s < 4; ++s) uf[s] = *(const bf16x8*)(PM + token * LDPM + PM_AX + g * 64 + 16 * s + 8 * hh);
#pragma unroll
    for (int part = 0; part < 2; ++part) { f32x16 v = splat16(0.f);
#pragma unroll
      for (int s = 0; s < 4; ++s) v = MFMA32(uf[s], wfr[part][s], v);
      vf[rb][0][part] = pack8(v, 0); vf[rb][1][part] = pack8(v, 1); }
  }
  f32x16 Ar = splat16(0.f), Ai = splat16(0.f);
#pragma unroll
  for (int rb = 0; rb < 4; ++rb)
#pragma unroll
    for (int sx = 0; sx < 2; ++sx) { const int pos = (32 * kq + r) * 128 + 32 * rb + 16 * sx + 8 * hh;
      const bf16x8 cf = *(const bf16x8*)(CP + pos), sf = *(const bf16x8*)(SP + pos), nsf = *(const bf16x8*)(NSP + pos);
      Ar = MFMA32(cf, vf[rb][sx][0], Ar); Ar = MFMA32(sf, vf[rb][sx][1], Ar);
      Ai = MFMA32(cf, vf[rb][sx][1], Ai); Ai = MFMA32(nsf, vf[rb][sx][0], Ai); }
#pragma unroll
  for (int i = 0; i < 16; ++i) { const int k1 = 32 * kq + crow(i, hh); const float rev = (float)(n2 * k1) * (1.f / 16384.f); const float cs = cosrev(rev), sn = sinrev(rev);
    const float ar = Ar[i] * cs + Ai[i] * sn, ai = Ai[i] * cs - Ar[i] * sn;
    const size_t o = ((((size_t)b * 128 + k1) * 6 + g) * 128 + n2) * 128 + 32 * mb + r; AP[o] = f2bf(ar); AP[o + 64] = f2bf(ai); }
}

DI void fourierB_item(const Params& p, int b, int k1, int g, lds8* lds) {
  const int tid = launder_tid(), lane = tid & 63, w = tid >> 6, r = lane & 31, hh = lane >> 5, mb = w & 1, kq = w >> 1;
  const bf16_t* X = (const bf16_t*)(p.ws + OFF_AP) + (((size_t)b * 128 + k1) * 6 + g) * 16384;
  const bf16_t* CN = (const bf16_t*)(p.ws + OFF_TAB) + 8192 + 3 * 16384; const bf16_t* SN = CN + 16384; bf16_t* Y = (bf16_t*)(p.ws + OFF_Y);
#pragma unroll
  for (int i = 0; i < 4; ++i) { const int e = tid + NT * i, row = e >> 4, ch = e & 15; *(LAS u32x4*)(lds + row * 272 + ch * 16) = *(const u32x4*)(X + row * 128 + ch * 8); }
  __syncthreads();
  f32x16 F = splat16(0.f);
#pragma unroll
  for (int s = 0; s < 8; ++s) {
    const bf16x8 cf = *(const bf16x8*)(CN + (32 * kq + r) * 128 + 16 * s + 8 * hh), sf = *(const bf16x8*)(SN + (32 * kq + r) * 128 + 16 * s + 8 * hh);
    bf16x8 xr, xi;
#pragma unroll
    for (int j = 0; j < 8; ++j) { const int row = 16 * s + 8 * hh + j; xr[j] = *(const LAS short*)(lds + row * 272 + (32 * mb + r) * 2); xi[j] = *(const LAS short*)(lds + row * 272 + (64 + 32 * mb + r) * 2); }
    F = MFMA32(cf, xr, F); F = MFMA32(sf, xi, F);
  }
#pragma unroll
  for (int i = 0; i < 16; ++i) { const int k2 = 32 * kq + crow(i, hh); const size_t idx = ((size_t)b * 16384 + k1 + 128 * k2) * LDY + Y_A + g * 64 + 32 * mb + r;
    Y[idx] = f2bf(F[i] * (1.f / 1024.f) * bf2f(Y[idx])); }
  __syncthreads();
}

DI void fourierC_item(const Params& p, int b, int g, int kc, lds8* lds) {
  const int tid = launder_tid();
  LAS float* V = (LAS float*)lds; LAS float* T64c = V + 32768; LAS float* T64s = T64c + 64; LAS float* T256c = T64s + 64; LAS float* T256s = T256c + 256;
  const bf16_t* PM = (const bf16_t*)(p.ws + OFF_PM); bf16_t* Y = (bf16_t*)(p.ws + OFF_Y);
  if (tid < 64) { T64c[tid] = cosrev((float)tid * (1.f / 64.f)); T64s[tid] = sinrev((float)tid * (1.f / 64.f)); }
  if (tid < 256) { T256c[tid] = cosrev((float)tid * (1.f / 256.f)); T256s[tid] = sinrev((float)tid * (1.f / 256.f)); }
  __syncthreads();
  for (int e = tid; e < 32768; e += NT) { const int n = e >> 7, mp = e & 127, m = mp & 63;
    const bf16_t* up = PM + (size_t)(TL + b * 256 + n) * LDPM + PM_AX + g * 64; float a = 0.f;
    for (int c8 = 0; c8 < 64; c8 += 8) { float u[8]; unpack8(*(const u32x4*)(up + c8), u);
#pragma unroll
      for (int j = 0; j < 8; ++j) { const int t = (m * (c8 + j)) & 63; a += u[j] * (mp < 64 ? T64c[t] : -T64s[t]); } }
    V[e] = a; }
  __syncthreads();
#pragma unroll
  for (int i = 0; i < 4; ++i) { const int e = tid + NT * i; const int k = kc * 32 + (e >> 6), m = e & 63; float a = 0.f;
    for (int n = 0; n < 256; ++n) { const int t = (k * n) & 255; a += T256c[t] * V[n * 128 + m] + T256s[t] * V[n * 128 + 64 + m]; }
    const size_t idx = (size_t)(TL + b * 256 + k) * LDY + Y_A + g * 64 + m; Y[idx] = f2bf(a * (1.f / 128.f) * bf2f(Y[idx])); }
  __syncthreads();
}

constexpr int KP = 144;
template <int NDB>
DI void attn_tile(const lds8* kb_, const lds8* vb_, const bf16x8 (&qf)[4], f32x16 (&O)[NDB], float& lsum, float negM, int mmode, int qi, int koff, int r, int pr, int hh) {
  f32x16 S[2];
#pragma unroll
  for (int kb = 0; kb < 2; ++kb) { S[kb] = splat16(negM);
#pragma unroll
    for (int s = 0; s < 4; ++s) { const bf16x8 kf = *(const LAS bf16x8*)(kb_ + (32 * kb + pr) * KP + (16 * s + 8 * hh) * 2); S[kb] = MFMA32(kf, qf[s], S[kb]); } }
  if (mmode != 0) {
#pragma unroll
    for (int kb = 0; kb < 2; ++kb)
#pragma unroll
      for (int i = 0; i < 16; ++i) { const int kj = koff + 32 * kb + 16 * (i >> 3) + 8 * hh + (i & 7); const bool ok = mmode == 1 ? (kj >= qi) : (kj <= qi); if (!ok) S[kb][i] = -1e30f; }
  }
#pragma unroll
  for (int kb = 0; kb < 2; ++kb)
#pragma unroll
    for (int i = 0; i < 16; ++i) { const float pv = __builtin_amdgcn_exp2f(S[kb][i]); lsum += pv; S[kb][i] = pv; }
#pragma unroll
  for (int kb = 0; kb < 2; ++kb)
#pragma unroll
    for (int s = 0; s < 2; ++s) { const bf16x8 pf = pack8(S[kb], s);
#pragma unroll
      for (int db = 0; db < NDB; ++db) { const bf16x8 vfr = *(const LAS bf16x8*)(vb_ + (32 * db + r) * KP + (32 * kb + 16 * s + 8 * hh) * 2); O[db] = MFMA32(vfr, pf, O[db]); } }
}

DI float gain_max(const float* g, int lane) { float v = fabsf(g[lane]);
#pragma unroll
  for (int o = 32; o >= 1; o >>= 1) v = fmaxf(v, __shfl_xor(v, o));
  return v; }

constexpr int DSTG = 36864;
DI void attn_diff_item(const Params& p, int l, int b, int h, int qb, bool ctxq, lds8* lds) {
  const int tid = launder_tid(), lane = tid & 63, w = tid >> 6, r = lane & 31, hh = lane >> 5, comp = w >> 2, rg = w & 3;
  const int pr = (r & ~12) | ((r & 4) << 1) | ((r & 8) >> 1);
  const bf16_t* PM = (const bf16_t*)(p.ws + OFF_PM); const bf16_t* VTD = (const bf16_t*)(p.ws + OFF_VTD); bf16_t* Y = (bf16_t*)(p.ws + OFF_Y);
  const float negM = -(8.f * LOG2E * gain_max(p.q_norm_d + l * 64, lane) * gain_max(p.k_norm_d + l * 64, lane));
  const size_t qrow = (size_t)(ctxq ? TL + b * 256 : b * 16384) + qb * 128 + rg * 32 + r;
  bf16x8 qf[4];
#pragma unroll
  for (int s = 0; s < 4; ++s) qf[s] = *(const bf16x8*)(PM + qrow * LDPM + PM_DQ + h * 128 + comp * 64 + 16 * s + 8 * hh);
  f32x16 O[4];
#pragma unroll
  for (int d = 0; d < 4; ++d) O[d] = splat16(0.f);
  float lsum = 0.f;
  const int nt = ctxq ? 4 : 260;
  const int lrow = tid >> 3, lch = tid & 7;
  const bf16_t* kbase_c = PM + (size_t)(TL + b * 256 + lrow) * LDPM + PM_DK + h * 128 + lch * 8;
  const bf16_t* kbase_l = PM + (size_t)(b * 16384 + lrow) * LDPM + PM_DK + h * 128 + lch * 8;
  const bf16_t* vbase = VTD + ((size_t)(b * 4 + h) * 128 + lrow) * NKEY + lch * 8;
  u32x4 st0, st1, st2, st3;
#define DLOAD(t_) do { const int t__ = (t_); const bf16_t* kp_ = t__ < 4 ? kbase_c + (size_t)t__ * 64 * LDPM : kbase_l + (size_t)(t__ - 4) * 64 * LDPM; \
    st0 = *(const u32x4*)kp_; st1 = *(const u32x4*)(kp_ + 64); st2 = *(const u32x4*)(vbase + t__ * 64); st3 = *(const u32x4*)(vbase + (size_t)64 * NKEY + t__ * 64); } while (0)
#define DWRITE(buf_) do { lds8* b__ = lds + (buf_) * DSTG; *(LAS u32x4*)(b__ + lrow * KP + lch * 16) = st0; *(LAS u32x4*)(b__ + 9216 + lrow * KP + lch * 16) = st1; \
    *(LAS u32x4*)(b__ + 18432 + lrow * KP + lch * 16) = st2; *(LAS u32x4*)(b__ + 18432 + (64 + lrow) * KP + lch * 16) = st3; } while (0)
  DLOAD(0); DWRITE(0); __syncthreads();
  for (int t = 0; t < nt; ++t) {
    const int cur = t & 1;
    if (t + 1 < nt) DLOAD(t + 1);
    attn_tile<4>(lds + cur * DSTG + comp * 9216, lds + cur * DSTG + 18432, qf, O, lsum, negM, 0, 0, 0, r, pr, hh);
    if (t + 1 < nt) DWRITE(cur ^ 1);
    __syncthreads();
  }
#undef DLOAD
#undef DWRITE
  lsum += __shfl_xor(lsum, 32);
  float la = p.lam_q1[l * 64 + lane] * p.lam_k1[l * 64 + lane], lb = p.lam_q2[l * 64 + lane] * p.lam_k2[l * 64 + lane];
#pragma unroll
  for (int o = 32; o >= 1; o >>= 1) { la += __shfl_xor(la, o); lb += __shfl_xor(lb, o); }
  const float lam_init = l == 0 ? 0.2f : (0.8f - 0.6f * 0.7408182206817179f);
  const float lam = __expf(la) - __expf(lb) + lam_init;
  const float inv = 1.f / lsum;
  LAS float* xch = (LAS float*)lds;
  if (comp == 1) {
#pragma unroll
    for (int d = 0; d < 4; ++d)
#pragma unroll
      for (int i = 0; i < 16; ++i) xch[(rg * 64 + d * 16 + i) * 64 + lane] = O[d][i] * inv * lam;
  }
  __syncthreads();
  if (comp == 0) {
    float ss = 0.f;
#pragma unroll
    for (int d = 0; d < 4; ++d)
#pragma unroll
      for (int i = 0; i < 16; ++i) { const float o = O[d][i] * inv - xch[(rg * 64 + d * 16 + i) * 64 + lane]; O[d][i] = o; ss += o * o; }
    ss += __shfl_xor(ss, 32);
    const float rs = rsqrtf(ss * (1.f / 128.f) + 1e-6f) * (1.f - lam_init);
    const float* sg = p.subln_d + l * 128;
    bf16_t* yrow = Y + qrow * LDY + Y_D + h * 128;
#pragma unroll
    for (int d = 0; d < 4; ++d)
#pragma unroll
      for (int a = 0; a < 4; ++a) { const int dv = 32 * d + 8 * a + 4 * hh; const u32x2 szr = *(const u32x2*)(yrow + dv); const f32x4 g4 = *(const f32x4*)(sg + dv);
        u32x2 o; o.x = pk2(O[d][4 * a + 0] * rs * g4[0] * bflo(szr.x), O[d][4 * a + 1] * rs * g4[1] * bfhi(szr.x));
        o.y = pk2(O[d][4 * a + 2] * rs * g4[2] * bflo(szr.y), O[d][4 * a + 3] * rs * g4[3] * bfhi(szr.y)); *(u32x2*)(yrow + dv) = o; }
  }
  __syncthreads();
}

constexpr int SSTG = 18432;
DI void attn_swa_item(const Params& p, int l, int b, int hk, int blk, bool ctxq, lds8* lds) {
  const int tid = launder_tid(), lane = tid & 63, w = tid >> 6, r = lane & 31, hh = lane >> 5, rg = w & 3, hp = w >> 2;
  const int pr = (r & ~12) | ((r & 4) << 1) | ((r & 8) >> 1);
  const bf16_t* PM = (const bf16_t*)(p.ws + OFF_PM); const bf16_t* VTB = (const bf16_t*)(p.ws + OFF_VTB); bf16_t* Y = (bf16_t*)(p.ws + OFF_Y);
  const float negM = -(8.f * LOG2E * gain_max(p.q_norm_b + l * 64, lane) * gain_max(p.k_norm_b + l * 64, lane));
  const size_t qrow = (size_t)(ctxq ? TL + b * 256 : b * 16384) + blk * 128 + rg * 32 + r;
  const int qi = rg * 32 + r;
  const int lrow = tid >> 3, lch = tid & 7;
  const bf16_t* vbase = VTB + ((size_t)(b * 2 + hk) * 64 + lrow) * NKEY + lch * 8;
  const int nt = ctxq ? 4 : 10;
#pragma unroll 1
  for (int ps = 0; ps < 2; ++ps) {
    const int hq = hk * 4 + ps * 2 + hp;
    bf16x8 qf[4];
#pragma unroll
    for (int s = 0; s < 4; ++s) qf[s] = *(const bf16x8*)(PM + qrow * LDPM + PM_BQ + hq * 64 + 16 * s + 8 * hh);
    f32x16 O[2]; O[0] = splat16(0.f); O[1] = splat16(0.f);
    float lsum = 0.f;
#pragma unroll 1
    for (int t = 0; t < nt; ++t) {
      int krow0, key0, mmode = 0, koff = 0;
      if (t < 4) { krow0 = TL + b * 256 + t * 64; key0 = t * 64; }
      else { const int bb = blk + ((t - 4) >> 1) - 1; if (bb < 0 || bb > 127) continue; koff = ((t - 4) & 1) * 64; const int nn = bb * 128 + koff; krow0 = b * 16384 + nn; key0 = 256 + nn; mmode = t < 6 ? 1 : (t < 8 ? 0 : 2); }
      const u32x4 st0 = *(const u32x4*)(PM + (size_t)(krow0 + lrow) * LDPM + PM_BK + hk * 64 + lch * 8); const u32x4 st1 = *(const u32x4*)(vbase + key0);
      __syncthreads();
      *(LAS u32x4*)(lds + lrow * KP + lch * 16) = st0; *(LAS u32x4*)(lds + 9216 + lrow * KP + lch * 16) = st1;
      __syncthreads();
      attn_tile<2>(lds, lds + 9216, qf, O, lsum, negM, mmode, qi, koff, r, pr, hh);
    }
    lsum += __shfl_xor(lsum, 32);
    lsum += __builtin_amdgcn_exp2f(p.sink_b[l * 8 + hq] * LOG2E + negM);
    const float i0 = 1.f / lsum;
    bf16_t* yrow = Y + qrow * LDY + Y_B + hq * 64;
#pragma unroll
    for (int d = 0; d < 2; ++d)
#pragma unroll
      for (int a = 0; a < 4; ++a) { const int dv = 32 * d + 8 * a + 4 * hh;
        const u32x2 szr = *(const u32x2*)(yrow + dv); u32x2 o; o.x = pk2(O[d][4 * a + 0] * i0 * bflo(szr.x), O[d][4 * a + 1] * i0 * bfhi(szr.x)); o.y = pk2(O[d][4 * a + 2] * i0 * bflo(szr.y), O[d][4 * a + 3] * i0 * bfhi(szr.y)); *(u32x2*)(yrow + dv) = o; }
  }
  __syncthreads();
}

DI void phase_elem(const Params& p, int l, lds8* lds) {
  const int tid = launder_tid(), lane = tid & 63, w = tid >> 6;
  for (int it = blockIdx.x * 8 + w; it < TT * 4; it += gridDim.x * 8) normrope_item(p, l, it, lane);
  for (int it = blockIdx.x * NT + tid; it < TT * 48; it += gridDim.x * NT) conv_item(p, l, it);
  for (int it = blockIdx.x; it < 1536; it += gridDim.x) { const int g = it % 6, n2 = (it / 6) % 128, b = it / 768; fourierA_item(p, b, n2, g); }
  if (l == 0) for (int it = blockIdx.x; it < 96; it += gridDim.x) { const int kc = it & 7, g = (it >> 3) % 6, b = it / 48; fourierC_item(p, b, g, kc, lds); }
}

DI void phase_mix(const Params& p, int l, lds8* lds) {
  for (int it = blockIdx.x; it < 1024; it += gridDim.x) { const int bh = it & 7, qb = it >> 3; attn_diff_item(p, l, bh >> 2, bh & 3, qb, false, lds); }
  for (int it = blockIdx.x; it < 512; it += gridDim.x) { const int bk = it & 3, blk = it >> 2; attn_swa_item(p, l, bk >> 1, bk & 1, blk, false, lds); }
  for (int it = blockIdx.x; it < 1536; it += gridDim.x) { const int g = it % 6, k1 = (it / 6) % 128, b = it / 768; fourierB_item(p, b, k1, g, lds); }
  if (l == 0) {
    for (int it = blockIdx.x; it < 16; it += gridDim.x) { const int bh = it & 7, qb = it >> 3; attn_diff_item(p, l, bh >> 2, bh & 3, qb, true, lds); }
    for (int it = blockIdx.x; it < 8; it += gridDim.x) { const int bk = it & 3, blk = it >> 2; attn_swa_item(p, l, bk >> 1, bk & 1, blk, true, lds); }
  }
}

DI void phase_gate(const Params& p, int l, lds8* lds) {
  const int tid = launder_tid(), wid = tid >> 6, lane = tid & 63, wr = wid >> 2, wc = wid & 3, fr = lane & 15, fq = lane >> 4;
  const bf16_t* H = (const bf16_t*)(p.ws + OFF_H); const bf16_t* WIN = (const bf16_t*)(p.ws + OFF_WIN); const bf16_t* WO = (const bf16_t*)(p.ws + OFF_WO);
  const bf16_t* Y = (const bf16_t*)(p.ws + OFF_Y); bf16_t* MIXED = (bf16_t*)(p.ws + OFF_MIXED);
  u32x2* SG = (u32x2*)(p.ws + OFF_SCR + (size_t)blockIdx.x * 393216); f32x4* SM = (f32x4*)(p.ws + OFF_SCR + (size_t)blockIdx.x * 393216 + 131072);
  const int nM = l == 0 ? 130 : 128;
  for (int i = 0;; ++i) {
    int pm, pn; if (!unit_next(nM, 4, i * gridDim.x + blockIdx.x, pm, pn)) break;
#pragma unroll 1
    for (int br = 0; br < 4; ++br) {
      const int ycol = br == 0 ? Y_A : (br == 1 ? Y_B : (br == 2 ? Y_C : Y_D));
      const size_t wooff = br == 0 ? 0 : (br == 1 ? 393216 : (br == 2 ? 917504 : 1310720));
      f32x4 acc[2][2][4][2];
      g8::gemm_tile<1024, 1024, 1024>(lds, H, WIN + (size_t)(5632 + br * 1024) * 1024, pm * 256, pn * 256, acc);
      { const int tid2 = launder_tid(); u32x2* SGt = SG + tid2 * 32;
#pragma unroll
      for (int ai = 0; ai < 2; ++ai)
#pragma unroll
        for (int bj = 0; bj < 2; ++bj)
#pragma unroll
          for (int m = 0; m < 4; ++m)
#pragma unroll
            for (int n = 0; n < 2; ++n) { const int slot = ((ai * 2 + bj) * 4 + m) * 2 + n; const f32x4 v = acc[ai][bj][m][n];
              u32x2 o; o.x = pk2(sigm(v[0]), sigm(v[1])); o.y = pk2(sigm(v[2]), sigm(v[3])); SGt[slot] = o; asm volatile("" ::: "memory"); } }
      if (br & 1) g8::gemm_tile<LDY, 512, 512>(lds, Y + ycol, WO + wooff, pm * 256, pn * 256, acc); else g8::gemm_tile<LDY, 384, 384>(lds, Y + ycol, WO + wooff, pm * 256, pn * 256, acc);
      { const int tid2 = launder_tid(); const u32x2* SGt = SG + tid2 * 32; f32x4* SMt = SM + tid2 * 32; const int wid2 = tid2 >> 6, lane2 = tid2 & 63, wr2 = wid2 >> 2, wc2 = wid2 & 3, fr2 = lane2 & 15, fq2 = lane2 >> 4;
#pragma unroll
      for (int ai = 0; ai < 2; ++ai)
#pragma unroll
        for (int bj = 0; bj < 2; ++bj)
#pragma unroll
          for (int m = 0; m < 4; ++m)
#pragma unroll
            for (int n = 0; n < 2; ++n) { const int slot = ((ai * 2 + bj) * 4 + m) * 2 + n; const f32x4 v = acc[ai][bj][m][n];
              const u32x2 gg = SGt[slot]; f32x4 mm = {0.f, 0.f, 0.f, 0.f}; if (br > 0) mm = SMt[slot];
              mm[0] += bflo(gg.x) * v[0]; mm[1] += bfhi(gg.x) * v[1]; mm[2] += bflo(gg.y) * v[2]; mm[3] += bfhi(gg.y) * v[3];
              if (br < 3) SMt[slot] = mm;
              else { const int row = pm * 256 + ai * 128 + wr2 * 64 + m * 16 + fr2, col = pn * 256 + bj * 128 + wc2 * 32 + n * 16 + fq2 * 4;
                u32x2 o; o.x = pk2(mm[0], mm[1]); o.y = pk2(mm[2], mm[3]); *(u32x2*)(MIXED + (size_t)row * 1024 + col) = o; } asm volatile("" ::: "memory"); } }
    }
  }
}

DI void phase_out(const Params& p, int l, lds8* lds) {
  const int tid = launder_tid(), wid = tid >> 6, lane = tid & 63, wr = wid >> 2, wc = wid & 3, fr = lane & 15, fq = lane >> 4;
  const bf16_t* MIXED = (const bf16_t*)(p.ws + OFF_MIXED); const bf16_t* WOUT = (const bf16_t*)(p.ws + OFF_WOUT) + (size_t)l * 1048576;
  const float* MOD = (const float*)(p.ws + OFF_MOD); float* CTX1 = (float*)(p.ws + OFF_CTX1);
  const float* xl = l == 0 ? p.x : p.out;
  const int nM = l == 0 ? 130 : 128;
  for (int i = 0;; ++i) {
    int pm, pn; if (!unit_next(nM, 4, i * gridDim.x + blockIdx.x, pm, pn)) break;
    f32x4 acc[2][2][4][2];
    g8::gemm_tile<1024, 1024, 1024>(lds, MIXED, WOUT, pm * 256, pn * 256, acc);
#pragma unroll
    for (int ai = 0; ai < 2; ++ai)
#pragma unroll
      for (int m = 0; m < 4; ++m) { const int row = pm * 256 + ai * 128 + wr * 64 + m * 16 + fr;
        const float* src; float* dst; int v;
        if (row < TL) { src = xl + (size_t)row * 1024; dst = p.out + (size_t)row * 1024; v = row >> 14; } else { src = p.ctx + (size_t)(row - TL) * 1024; dst = CTX1 + (size_t)(row - TL) * 1024; v = 2; }
        const float* gate = MOD + (l * 3 + v) * 3072 + 2048;
#pragma unroll
        for (int bj = 0; bj < 2; ++bj)
#pragma unroll
          for (int n = 0; n < 2; ++n) { const int col = pn * 256 + bj * 128 + wc * 32 + n * 16 + fq * 4;
            const f32x4 xv = *(const f32x4*)(src + col), gv = *(const f32x4*)(gate + col); *(f32x4*)(dst + col) = xv + gv * acc[ai][bj][m][n]; } }
  }
}

__global__ void __launch_bounds__(NT) hybrid_fwd(Params p) {
  extern __shared__ __attribute__((aligned(16))) unsigned char lds_raw[];
  lds8* lds = (lds8*)lds_raw;
  cg::grid_group grid = cg::this_grid();
  for (int it = blockIdx.x; it < PREP_ITEMS + 98; it += gridDim.x) {
    if (it < PREP_ITEMS) prep_item(p, 0, it, lds);
    else if (it < PREP_ITEMS + 96) mod_item(p, it - PREP_ITEMS, lds);
    else tables_item(p, it - PREP_ITEMS - 96);
  }
  grid.sync();
#pragma unroll 1
  for (int l = 0; l < 2; ++l) {
    phase_norm(p, l);
    grid.sync();
    phase_inproj(p, lds);
    grid.sync();
    phase_elem(p, l, lds);
    grid.sync();
    phase_mix(p, l, lds);
    grid.sync();
    phase_gate(p, l, lds);
    grid.sync();
    phase_out(p, l, lds);
    if (l == 0) for (int it = blockIdx.x; it < PREP_ITEMS; it += gridDim.x) prep_item(p, 1, it, lds);
    grid.sync();
  }
}

extern "C" void kernel_launch(void* const* d_in, const int* in_sizes, int n_in, void* d_out, int out_size, void* d_ws, size_t ws_size, hipStream_t stream) {
  static int grid_blocks = 0;
  if (grid_blocks == 0) {
    if (n_in != 24 || ws_size < WS_END) { fprintf(stderr, "kernel_launch: unexpected n_in %d or ws_size %zu (< %zu)\n", n_in, ws_size, (size_t)WS_END); grid_blocks = -1; return; }
    int dev = 0, cus = 0, per_cu = 0;
    hipGetDevice(&dev); hipDeviceGetAttribute(&cus, hipDeviceAttributeMultiprocessorCount, dev);
    hipFuncSetAttribute((const void*)hybrid_fwd, hipFuncAttributeMaxDynamicSharedMemorySize, LDS_BYTES);
    hipOccupancyMaxActiveBlocksPerMultiprocessor(&per_cu, (const void*)hybrid_fwd, NT, LDS_BYTES);
    if (per_cu < 1) per_cu = 1;
    grid_blocks = cus * per_cu;
    (void)hipGetLastError();
  }
  if (grid_blocks < 0) return;
  Params p{};
  const float** pp = (const float**)&p;
  for (int i = 0; i < 24; ++i) pp[i] = (const float*)d_in[i];
  p.out = (float*)d_out; p.ws = (unsigned char*)d_ws;
  void* args[] = {&p};
  hipError_t e = hipLaunchCooperativeKernel((const void*)hybrid_fwd, dim3(grid_blocks), dim3(NT), args, LDS_BYTES, stream);
  if (e != hipSuccess) fprintf(stderr, "cooperative launch failed: %s (grid %d)\n", hipGetErrorString(e), grid_blocks);
}
```

```cpp
#include <hip/hip_runtime.h>
#include <hip/hip_cooperative_groups.h>
#include <stdint.h>
#include <stdio.h>
namespace cg = cooperative_groups;

typedef unsigned short bf16_t;
typedef short bf16x8 __attribute__((ext_vector_type(8)));
typedef float f32x2 __attribute__((ext_vector_type(2)));
typedef float f32x4 __attribute__((ext_vector_type(4)));
typedef float f32x16 __attribute__((ext_vector_type(16)));
typedef unsigned u32x2 __attribute__((ext_vector_type(2)));
typedef unsigned u32x4 __attribute__((ext_vector_type(4)));
typedef __bf16 bf16x2v __attribute__((ext_vector_type(2)));
#define LAS __attribute__((address_space(3)))
typedef LAS unsigned char lds8;
#define DI __device__ __forceinline__
#define MFMA32(a, b, c) __builtin_amdgcn_mfma_f32_32x32x16_bf16((a), (b), (c), 0, 0, 0)
#define MFMA16(a, b, c) __builtin_amdgcn_mfma_f32_16x16x32_bf16((a), (b), (c), 0, 0, 0)

constexpr int NT = 512;
constexpr int TT = 33280;
constexpr int TL = 32768;
constexpr int NKEY = 16640;
constexpr int LDPM = 3200, LDY = 1792;
constexpr int PM_AX = 0, PM_BQ = 384, PM_BK = 896, PM_CX = 1024, PM_CB = 1408, PM_CC = 1792, PM_DQ = 2176, PM_DK = 2688;
constexpr int Y_A = 0, Y_B = 384, Y_C = 896, Y_D = 1280;
constexpr size_t OFF_H = 0ull, OFF_PM = 68157440ull, OFF_Y = 281149440ull, OFF_WIN = 400424960ull, OFF_WO = 420347904ull,
                 OFF_WOUT = 424017920ull, OFF_AP = 428212224ull, OFF_VTD = 478543872ull, OFF_VTB = 512622592ull,
                 OFF_CTX1 = 521142272ull, OFF_MOD = 523239424ull, OFF_ROPE = 523313152ull, OFF_TAB = 523345920ull,
                 OFF_VC = 523526144ull, OFF_CG = 525099008ull, OFF_BAR = 529293312ull, WS_END = 529309696ull;
constexpr size_t OFF_MIXED = OFF_AP;
constexpr size_t OFF_SCR = OFF_PM;
constexpr int LDS_BYTES = 143360;
constexpr float QSCALE = 0.18033688011112042f;
constexpr float LOG2E = 1.4426950408889634f;

struct Params {
  const float *x, *c, *ctx, *c_ctx, *norm_g, *w_mod, *b_mod, *w_in, *q_norm_b, *k_norm_b, *sink_b, *conv_w,
              *q_norm_d, *k_norm_d, *lam_q1, *lam_k1, *lam_q2, *lam_k2, *subln_d, *w_o_a, *w_o_b, *w_o_c, *w_o_d, *w_out;
  float* out; unsigned char* ws;
};

DI int launder_tid() { int t = threadIdx.x; asm volatile("" : "+v"(t)); return t; }
template <int M> DI float shx(float v) { return __int_as_float(__builtin_amdgcn_ds_swizzle(__float_as_int(v), (M << 10) | 0x1f)); }
DI float sum32(float v) { const unsigned x = __float_as_uint(v); const auto r = __builtin_amdgcn_permlane32_swap(x, x, false, false); return __uint_as_float(r[0]) + __uint_as_float(r[1]); }
DI float max32(float v) { const unsigned x = __float_as_uint(v); const auto r = __builtin_amdgcn_permlane32_swap(x, x, false, false); return fmaxf(__uint_as_float(r[0]), __uint_as_float(r[1])); }
DI float wave_sum(float v) { v = sum32(v); v += shx<16>(v); v += shx<8>(v); v += shx<4>(v); v += shx<2>(v); v += shx<1>(v); return v; }
DI float wave_max(float v) { v = max32(v); v = fmaxf(v, shx<16>(v)); v = fmaxf(v, shx<8>(v)); v = fmaxf(v, shx<4>(v)); v = fmaxf(v, shx<2>(v)); v = fmaxf(v, shx<1>(v)); return v; }
DI unsigned pk2(float lo, float hi) { f32x2 v = {lo, hi}; return __builtin_bit_cast(unsigned, __builtin_convertvector(v, bf16x2v)); }
DI bf16_t f2bf(float x) { return (bf16_t)(pk2(x, 0.f) & 0xffffu); }
DI float bf2f(bf16_t u) { return __uint_as_float(((unsigned)u) << 16); }
DI float bflo(unsigned u) { return __uint_as_float(u << 16); }
DI float bfhi(unsigned u) { return __uint_as_float(u & 0xffff0000u); }
DI float siluf(float x) { return x * __builtin_amdgcn_rcpf(1.f + __builtin_amdgcn_exp2f(-1.4426950408889634f * x)); }
DI float sigm(float x) { return __builtin_amdgcn_rcpf(1.f + __builtin_amdgcn_exp2f(-1.4426950408889634f * x)); }
DI int crow(int i, int h) { return (i & 3) + 8 * (i >> 2) + 4 * h; }
DI float cosrev(float r) { return __builtin_amdgcn_cosf(r); }
DI float sinrev(float r) { return __builtin_amdgcn_sinf(r); }
DI bf16x8 pack8(const f32x16& v, int s) {
  u32x4 w;
  w.x = pk2(v[8 * s + 0], v[8 * s + 1]); w.y = pk2(v[8 * s + 2], v[8 * s + 3]);
  w.z = pk2(v[8 * s + 4], v[8 * s + 5]); w.w = pk2(v[8 * s + 6], v[8 * s + 7]);
  return __builtin_bit_cast(bf16x8, w);
}
DI f32x16 splat16(float x) { f32x16 v; _Pragma("unroll") for (int i = 0; i < 16; ++i) v[i] = x; return v; }

DI void tconv_tile(const float* __restrict__ src, int N, bf16_t* __restrict__ dst, int K, int tk, int tn, LAS float* sm) {
  const int t = launder_tid();
#pragma unroll
  for (int i = 0; i < 8; ++i) { const int e = t + i * NT, r = e >> 6, c = e & 63; sm[r * 65 + c] = src[(size_t)(tk * 64 + r) * N + tn * 64 + c]; }
  __syncthreads();
  { const int n = t >> 3, kc = t & 7; u32x4 w;
    w.x = pk2(sm[(kc * 8 + 0) * 65 + n], sm[(kc * 8 + 1) * 65 + n]); w.y = pk2(sm[(kc * 8 + 2) * 65 + n], sm[(kc * 8 + 3) * 65 + n]);
    w.z = pk2(sm[(kc * 8 + 4) * 65 + n], sm[(kc * 8 + 5) * 65 + n]); w.w = pk2(sm[(kc * 8 + 6) * 65 + n], sm[(kc * 8 + 7) * 65 + n]);
    *(u32x4*)(dst + (size_t)(tn * 64 + n) * K + tk * 64 + kc * 8) = w; }
  __syncthreads();
}

DI void prep_item(const Params& p, int l, int it, lds8* lds) {
  bf16_t* WIN = (bf16_t*)(p.ws + OFF_WIN); bf16_t* WO = (bf16_t*)(p.ws + OFF_WO); bf16_t* WOUT = (bf16_t*)(p.ws + OFF_WOUT);
  const float* src; bf16_t* dst; int K, N, ti;
  if (it < 2432) { src = p.w_in + (size_t)l * 1024 * 9728; dst = WIN; K = 1024; N = 9728; ti = it; }
  else if (it < 2528) { src = p.w_o_a + (size_t)l * 384 * 1024; dst = WO; K = 384; N = 1024; ti = it - 2432; }
  else if (it < 2656) { src = p.w_o_b + (size_t)l * 512 * 1024; dst = WO + 393216; K = 512; N = 1024; ti = it - 2528; }
  else if (it < 2752) { src = p.w_o_c + (size_t)l * 384 * 1024; dst = WO + 917504; K = 384; N = 1024; ti = it - 2656; }
  else if (it < 2880) { src = p.w_o_d + (size_t)l * 512 * 1024; dst = WO + 1310720; K = 512; N = 1024; ti = it - 2752; }
  else { src = p.w_out + (size_t)l * 1024 * 1024; dst = WOUT + (size_t)l * 1048576; K = 1024; N = 1024; ti = it - 2880; }
  const int ntk = K / 64; const int tk = ti % ntk, tn = ti / ntk;
  tconv_tile(src, N, dst, K, tk, tn, (LAS float*)lds);
}
constexpr int PREP_ITEMS = 3136;

DI void mod_item(const Params& p, int mi, lds8* lds) {
  const int l2 = mi / 48, jc = mi % 48, tid = threadIdx.x;
  LAS float* ssil = (LAS float*)lds; LAS float* part = ssil + 3072;
  for (int e = tid; e < 3072; e += NT) { const int v = e >> 10, k = e & 1023; const float cv = v < 2 ? p.c[v * 1024 + k] : p.c_ctx[k]; ssil[e] = siluf(cv); }
  __syncthreads();
  const int col = tid & 63, ks = tid >> 6; const int j = jc * 64 + col;
  float a0 = 0.f, a1 = 0.f, a2 = 0.f; const float* w = p.w_mod + (size_t)l2 * 1024 * 3072 + j;
#pragma unroll 16
  for (int k = ks * 128; k < ks * 128 + 128; ++k) { const float wv = w[(size_t)k * 3072]; a0 += ssil[k] * wv; a1 += ssil[1024 + k] * wv; a2 += ssil[2048 + k] * wv; }
  part[(ks * 3 + 0) * 64 + col] = a0; part[(ks * 3 + 1) * 64 + col] = a1; part[(ks * 3 + 2) * 64 + col] = a2;
  __syncthreads();
  if (tid < 192) { const int v = tid >> 6, cc = tid & 63; float s = 0.f;
    for (int q = 0; q < 8; ++q) s += part[(q * 3 + v) * 64 + cc];
    float* MOD = (float*)(p.ws + OFF_MOD); MOD[(l2 * 3 + v) * 3072 + jc * 64 + cc] = s + p.b_mod[l2 * 3072 + jc * 64 + cc]; }
  __syncthreads();
}

DI void tables_item(const Params& p, int which) {
  const int tid = launder_tid();
  if (which == 0) {
    float* RT = (float*)(p.ws + OFF_ROPE);
    for (int e = tid; e < 4096; e += NT) { const int pos = e >> 4, i = e & 15;
      const float inv = exp2f(-(float)i * (13.287712379549449f / 16.f)); const float ang = (float)pos * inv;
      float rev = ang * 0.15915494309189535f; rev -= floorf(rev);
      RT[2 * e] = cosrev(rev); RT[2 * e + 1] = sinrev(rev); }
  } else {
    bf16_t* WcT = (bf16_t*)(p.ws + OFF_TAB); bf16_t* CP = WcT + 8192; bf16_t* SP = CP + 16384; bf16_t* NSP = SP + 16384; bf16_t* CN = NSP + 16384; bf16_t* SN = CN + 16384;
    for (int e = tid; e < 16384; e += NT) { const int k = e >> 7, pos = e & 127;
      const int tn = (k * pos) & 127; const float rn = (float)tn * (1.f / 128.f);
      CN[e] = f2bf(cosrev(rn)); SN[e] = f2bf(sinrev(rn));
      const int j = pos & 7, h = (pos >> 3) & 1, s = (pos >> 4) & 1, rb = pos >> 5; const int n1 = 32 * rb + 16 * s + 8 * (j >> 2) + 4 * h + (j & 3);
      const int tp = (k * n1) & 127; const float rp = (float)tp * (1.f / 128.f); const float cs = cosrev(rp), sn = sinrev(rp);
      CP[e] = f2bf(cs); SP[e] = f2bf(sn); NSP[e] = f2bf(-sn); }
    for (int e = tid; e < 8192; e += NT) { const int mp = e >> 6, c = e & 63; const int m = mp & 63; const int t = (m * c) & 63; const float rr = (float)t * (1.f / 64.f);
      WcT[e] = f2bf(mp < 64 ? cosrev(rr) : -sinrev(rr)); }
  }
}

DI void phase_norm(const Params& p, int l) {
  const int tid = launder_tid(), lane = tid & 63, w = tid >> 6;
  bf16_t* H = (bf16_t*)(p.ws + OFF_H); const float* MOD = (const float*)(p.ws + OFF_MOD);
  const float* xl = l == 0 ? p.x : p.out; const float* xc = l == 0 ? p.ctx : (const float*)(p.ws + OFF_CTX1);
  const float* ng = p.norm_g + l * 1024;
#pragma unroll 1
  for (int v = 0; v < 3; ++v) {
    const int r0 = v < 2 ? v * 16384 : TL, r1 = v < 2 ? (v + 1) * 16384 : TT;
    const float* md = MOD + (l * 3 + v) * 3072;
    f32x4 ga[4], sb[4];
#pragma unroll
    for (int i = 0; i < 4; ++i) { const int col = (lane + 64 * i) * 4; const f32x4 g = *(const f32x4*)(ng + col), sc = *(const f32x4*)(md + 1024 + col); ga[i] = g * (1.f + sc); sb[i] = *(const f32x4*)(md + col); }
#pragma unroll 2
    for (int R = r0 + blockIdx.x * 8 + w; R < r1; R += gridDim.x * 8) {
      const float* src = v < 2 ? xl + (size_t)R * 1024 : xc + (size_t)(R - TL) * 1024;
      f32x4 xv[4]; float ss = 0.f;
#pragma unroll
      for (int i = 0; i < 4; ++i) { xv[i] = *(const f32x4*)(src + (lane + 64 * i) * 4); ss += xv[i][0] * xv[i][0] + xv[i][1] * xv[i][1] + xv[i][2] * xv[i][2] + xv[i][3] * xv[i][3]; }
      ss = wave_sum(ss);
      const float rs = rsqrtf(ss * (1.f / 1024.f) + 1e-6f);
#pragma unroll
      for (int i = 0; i < 4; ++i) { const int col = (lane + 64 * i) * 4; const f32x4 hv = xv[i] * rs * ga[i] + sb[i];
        u32x2 o; o.x = pk2(hv[0], hv[1]); o.y = pk2(hv[2], hv[3]); *(u32x2*)(H + (size_t)R * 1024 + col) = o; }
    }
  }
}

namespace g8 {
constexpr int BK = 64, HALF = 128, HTB = HALF * BK * 2;
DI int lds_byte(int r, int c) { const int st = (r >> 4) * 2 + (c >> 5), rr = r & 15, cc = c & 31, ob = rr * 64 + cc * 2; return st * 1024 + (ob ^ (((ob >> 9) & 1) << 5)); }
DI void stage_rc(int b, int& R, int& C) { const int st = b / 1024, sb = b % 1024, swz = sb ^ (((sb >> 9) & 1) << 5); R = (st >> 1) * 16 + swz / 64; C = (st & 1) * 32 + (swz % 64) / 2; }

#define G8_SA(b, h) (((b) * 2 + (h)) * HTB)
#define G8_SB(b, h) ((4 + (b) * 2 + (h)) * HTB)
#define G8_STAGE(bufoff, gbase, ld, voff, row0, kt) do { _Pragma("unroll") for (int _i = 0; _i < 2; ++_i) \
    __builtin_amdgcn_global_load_lds((const unsigned*)((gbase) + (size_t)(row0) * (ld) + (size_t)(kt) * BK + (voff)[_i]), (LAS unsigned*)(lds + (bufoff) + tid * 16 + _i * 8192), 16, 0, 0); } while (0)
#define G8_STA(bufoff, half, kt) G8_STAGE(bufoff, A, lda, voffA, brow + (half) * HALF, kt)
#define G8_STB(bufoff, half, kt) G8_STAGE(bufoff, Bt, ldb, voffB, bcol + (half) * HALF, kt)
#define G8_LDA(dst, b, h) do { _Pragma("unroll") for (int m = 0; m < 4; ++m) _Pragma("unroll") for (int k = 0; k < 2; ++k) dst[m][k] = *(const LAS bf16x8*)(lds + G8_SA(b, h) + aoff + m * 2048 + k * 1024); } while (0)
#define G8_LDB(dst, b, h) do { _Pragma("unroll") for (int n = 0; n < 2; ++n) _Pragma("unroll") for (int k = 0; k < 2; ++k) dst[n][k] = *(const LAS bf16x8*)(lds + G8_SB(b, h) + boff + n * 2048 + k * 1024); } while (0)
#define G8_MMA(ai, bj, At_, Bt_) do { __builtin_amdgcn_s_setprio(1); _Pragma("unroll") for (int m = 0; m < 4; ++m) _Pragma("unroll") for (int n = 0; n < 2; ++n) _Pragma("unroll") for (int k = 0; k < 2; ++k) \
    acc[ai][bj][m][n] = MFMA16(Bt_[n][k], At_[m][k], acc[ai][bj][m][n]); __builtin_amdgcn_s_setprio(0); } while (0)
#define G8_WAIT_V(n) asm volatile("s_waitcnt vmcnt(" #n ")" ::: "memory")
#define G8_WAIT_L(n) asm volatile("s_waitcnt lgkmcnt(" #n ")" ::: "memory")
#define G8_BAR __builtin_amdgcn_s_barrier()
#define G8_SCHED __builtin_amdgcn_sched_barrier(0)

template <int lda, int ldb>
DI void gemm_issue0(lds8* lds, const bf16_t* __restrict__ A, const bf16_t* __restrict__ Bt, int brow, int bcol) {
  const int tid = launder_tid();
  unsigned voffA[2], voffB[2];
#pragma unroll
  for (int i = 0; i < 2; ++i) { int R, C; stage_rc(tid * 16 + i * 8192, R, C); voffA[i] = (unsigned)(R * lda + C); voffB[i] = (unsigned)(R * ldb + C); }
  G8_STB(G8_SB(0, 0), 0, 0); G8_STA(G8_SA(0, 0), 0, 0);
  G8_STB(G8_SB(0, 1), 1, 0); G8_STA(G8_SA(0, 1), 1, 0);
}
template <int lda, int ldb, int K>
DI void gemm_main(lds8* lds, const bf16_t* __restrict__ A, const bf16_t* __restrict__ Bt, int brow, int bcol, f32x4 (&acc)[2][2][4][2]) {
  const int tid = launder_tid(), wid = tid >> 6, lane = tid & 63, wr = wid >> 2, wc = wid & 3, fr = lane & 15, fq = lane >> 4;
  unsigned voffA[2], voffB[2];
#pragma unroll
  for (int i = 0; i < 2; ++i) { int R, C; stage_rc(tid * 16 + i * 8192, R, C); voffA[i] = (unsigned)(R * lda + C); voffB[i] = (unsigned)(R * ldb + C); }
  const int aoff = lds_byte(wr * 64 + fr, fq * 8), boff = lds_byte(wc * 32 + fr, fq * 8);
#pragma unroll
  for (int a = 0; a < 2; ++a)
#pragma unroll
    for (int b = 0; b < 2; ++b)
#pragma unroll
      for (int m = 0; m < 4; ++m)
#pragma unroll
        for (int n = 0; n < 2; ++n) acc[a][b][m][n] = (f32x4){0.f, 0.f, 0.f, 0.f};
  bf16x8 At[4][2], B0[2][2], B1[2][2];
  constexpr int nt = K / BK;
  if (wr == 1) G8_BAR;
  G8_WAIT_V(0); G8_BAR;
  G8_STB(G8_SB(1, 0), 0, 1); G8_STA(G8_SA(1, 0), 0, 1); G8_STB(G8_SB(1, 1), 1, 1);
  G8_WAIT_V(6); G8_BAR;
  for (int t = 0; t < nt - 2; t += 2) {
    G8_LDB(B0, 0, 0); G8_SCHED; G8_LDA(At, 0, 0); G8_STA(G8_SA(1, 1), 1, t + 1);
    G8_WAIT_L(8); G8_BAR; G8_WAIT_L(0); G8_MMA(0, 0, At, B0); G8_BAR; G8_SCHED;
    G8_LDB(B1, 0, 1); G8_STB(G8_SB(0, 0), 0, t + 2);
    G8_BAR; G8_WAIT_L(0); G8_MMA(0, 1, At, B1); G8_BAR;
    G8_LDA(At, 0, 1); G8_STA(G8_SA(0, 0), 0, t + 2);
    G8_BAR; G8_WAIT_L(0); G8_MMA(1, 0, At, B0); G8_BAR; G8_SCHED;
    G8_STB(G8_SB(0, 1), 1, t + 2);
    G8_WAIT_V(6); G8_BAR; G8_MMA(1, 1, At, B1); G8_BAR;
    G8_LDB(B0, 1, 0); G8_SCHED; G8_LDA(At, 1, 0); G8_STA(G8_SA(0, 1), 1, t + 2);
    G8_WAIT_L(8); G8_BAR; G8_WAIT_L(0); G8_MMA(0, 0, At, B0); G8_BAR; G8_SCHED;
    G8_LDB(B1, 1, 1); G8_STB(G8_SB(1, 0), 0, t + 3);
    G8_BAR; G8_WAIT_L(0); G8_MMA(0, 1, At, B1); G8_BAR;
    G8_LDA(At, 1, 1); G8_STA(G8_SA(1, 0), 0, t + 3);
    G8_BAR; G8_WAIT_L(0); G8_MMA(1, 0, At, B0); G8_BAR; G8_SCHED;
    G8_STB(G8_SB(1, 1), 1, t + 3);
    G8_WAIT_V(6); G8_BAR; G8_MMA(1, 1, At, B1); G8_BAR;
  }
  { G8_LDB(B0, 0, 0); G8_LDA(At, 0, 0); G8_STA(G8_SA(1, 1), 1, nt - 1);
    G8_BAR; G8_WAIT_L(0); G8_MMA(0, 0, At, B0); G8_BAR;
    G8_LDB(B1, 0, 1); G8_BAR; G8_WAIT_L(0); G8_MMA(0, 1, At, B1); G8_BAR;
    G8_LDA(At, 0, 1); G8_WAIT_V(4); G8_BAR; G8_WAIT_L(0); G8_MMA(1, 0, At, B0); G8_MMA(1, 1, At, B1); G8_BAR; }
  { G8_LDB(B0, 1, 0); G8_LDA(At, 1, 0); G8_WAIT_V(2); G8_BAR; G8_WAIT_L(0); G8_MMA(0, 0, At, B0); G8_BAR;
    G8_LDB(B1, 1, 1); G8_WAIT_V(0); G8_BAR; G8_WAIT_L(0); G8_MMA(0, 1, At, B1); G8_BAR;
    G8_LDA(At, 1, 1); G8_BAR; G8_WAIT_L(0); G8_MMA(1, 0, At, B0); G8_MMA(1, 1, At, B1); G8_BAR; }
  if (wr == 0) G8_BAR;
  __syncthreads();
}
template <int lda, int ldb, int K>
DI void gemm_tile(lds8* lds, const bf16_t* __restrict__ A, const bf16_t* __restrict__ Bt, int brow, int bcol, f32x4 (&acc)[2][2][4][2]) { gemm_issue0<lda, ldb>(lds, A, Bt, brow, bcol); gemm_main<lda, ldb, K>(lds, A, Bt, brow, bcol, acc); }
struct Desc { const char* A; const char* B; int lda, ldb, nt, pm, pn, aux; };
DI void set_voff(int tid, int lda, int ldb, unsigned (&voffA)[2], unsigned (&voffB)[2]) {
#pragma unroll
  for (int i = 0; i < 2; ++i) { int R, C; stage_rc(tid * 16 + i * 8192, R, C); voffA[i] = (unsigned)(R * lda + C) * 2u; voffB[i] = (unsigned)(R * ldb + C) * 2u; }
}
#define GS_STAGE(bufoff, gbase, voff) do { _Pragma("unroll") for (int _i = 0; _i < 2; ++_i) \
    __builtin_amdgcn_global_load_lds((const unsigned*)((const char*)(gbase) + (voff)[_i]), (LAS unsigned*)(lds + (bufoff) + ldsw + _i * 8192), 16, 0, 0); } while (0)
template <class Ctx>
DI void gemm_stream(lds8* lds, Ctx& C) {
  const int tid = launder_tid(), wid = __builtin_amdgcn_readfirstlane(tid >> 6), lane = tid & 63, wr = wid >> 2, wc = wid & 3, fr = lane & 15, fq = lane >> 4;
  const unsigned ldsw = (unsigned)wid * 1024u;
  const int aoff = lds_byte(wr * 64 + fr, fq * 8), boff = lds_byte(wc * 32 + fr, fq * 8);
  constexpr size_t kstep = (size_t)(BK * 2);
  Desc cur, nxt; int ui = 0;
  if (!C.next(0, cur)) return;
  f32x4 acc[2][2][4][2];
#pragma unroll
  for (int a = 0; a < 2; ++a)
#pragma unroll
    for (int b = 0; b < 2; ++b)
#pragma unroll
      for (int m = 0; m < 4; ++m)
#pragma unroll
        for (int n = 0; n < 2; ++n) acc[a][b][m][n] = (f32x4){0.f, 0.f, 0.f, 0.f};
  bf16x8 At[4][2], B0[2][2], B1[2][2];
  unsigned voffA[2], voffB[2]; set_voff(tid, cur.lda, cur.ldb, voffA, voffB);
  size_t hsA = (size_t)HALF * cur.lda * 2, hsB = (size_t)HALF * cur.ldb * 2;
  const char* cA = cur.A; const char* cB = cur.B;
  GS_STAGE(G8_SB(0, 0), cB, voffB); GS_STAGE(G8_SB(0, 1), cB + hsB, voffB); GS_STAGE(G8_SA(0, 0), cA, voffA); GS_STAGE(G8_SA(0, 1), cA + hsA, voffA);
  if (wr == 1) G8_BAR;
  G8_WAIT_V(2); G8_BAR;
  GS_STAGE(G8_SB(1, 0), cB + kstep, voffB); GS_STAGE(G8_SA(1, 0), cA + kstep, voffA); GS_STAGE(G8_SB(1, 1), cB + hsB + kstep, voffB);
  G8_WAIT_V(6); G8_BAR;
  for (;;) {
    const bool has_next = C.next(ui + 1, nxt);
    const char* nA = has_next ? nxt.A : cA; const char* nB = has_next ? nxt.B : cB;
    const int nt = cur.nt;
#pragma unroll 1
    for (int t = 0; t < nt; t += 2) {
      const bool last = (t == nt - 2);
      const char* a1 = cA + (size_t)(t + 1) * kstep;
      G8_LDB(B0, 0, 0); G8_LDB(B1, 0, 1); G8_SCHED; G8_LDA(At, 0, 0); GS_STAGE(G8_SA(1, 1), a1 + hsA, voffA);
      if (last && has_next) { set_voff(tid, nxt.lda, nxt.ldb, voffA, voffB); hsA = (size_t)HALF * nxt.lda * 2; hsB = (size_t)HALF * nxt.ldb * 2; }
      const char* a2 = last ? nA : cA + (size_t)(t + 2) * kstep; const char* b2 = last ? nB : cB + (size_t)(t + 2) * kstep;
      const char* a3 = a2 + kstep; const char* b3 = b2 + kstep;
      G8_WAIT_V(8); G8_WAIT_L(0); G8_BAR; G8_MMA(0, 0, At, B0); G8_MMA(0, 1, At, B1); G8_BAR; G8_SCHED;
      G8_LDA(At, 0, 1); GS_STAGE(G8_SB(0, 0), b2, voffB); GS_STAGE(G8_SB(0, 1), b2 + hsB, voffB); GS_STAGE(G8_SA(0, 0), a2, voffA);
      G8_WAIT_V(8); G8_WAIT_L(0); G8_BAR; G8_MMA(1, 0, At, B0); G8_MMA(1, 1, At, B1); G8_BAR; G8_SCHED;
      G8_LDB(B0, 1, 0); G8_LDB(B1, 1, 1); G8_SCHED; G8_LDA(At, 1, 0); GS_STAGE(G8_SA(0, 1), a2 + hsA, voffA);
      G8_WAIT_V(8); G8_WAIT_L(0); G8_BAR; G8_MMA(0, 0, At, B0); G8_MMA(0, 1, At, B1); G8_BAR; G8_SCHED;
      G8_LDA(At, 1, 1); GS_STAGE(G8_SB(1, 0), b3, voffB); GS_STAGE(G8_SB(1, 1), b3 + hsB, voffB); GS_STAGE(G8_SA(1, 0), a3, voffA);
      G8_WAIT_V(8); G8_WAIT_L(0); G8_BAR; G8_MMA(1, 0, At, B0); G8_MMA(1, 1, At, B1); G8_BAR; G8_SCHED;
    }
    if (wr == 0) G8_BAR;
    C.epi(cur, acc);
    if (!has_next) break;
#pragma unroll
    for (int a = 0; a < 2; ++a)
#pragma unroll
      for (int b = 0; b < 2; ++b)
#pragma unroll
        for (int m = 0; m < 4; ++m)
#pragma unroll
          for (int n = 0; n < 2; ++n) acc[a][b][m][n] = (f32x4){0.f, 0.f, 0.f, 0.f};
    cur = nxt; cA = nA; cB = nB; ++ui;
    if (wr == 1) G8_BAR;
  }
  G8_WAIT_V(0);
  G8_BAR;
  __syncthreads();
}
}

DI bool unit_next(int nM, int nN, int L, int& pm, int& pn) {
  const int nwg = nM * nN; if (L >= nwg) return false;
  int wgid = L; { const int q = nwg / 8, r = nwg % 8, xcd = wgid % 8, off = wgid / 8; wgid = (xcd < r ? xcd * (q + 1) : r * (q + 1) + (xcd - r) * q) + off; }
  const int nig = 8 * nN, gid = wgid / nig, fm = gid * 8, gsz = (nM - fm) < 8 ? (nM - fm) : 8;
  pm = fm + ((wgid % nig) % gsz); pn = (wgid % nig) / gsz; return true;
}

struct InprojCtx {
  const Params& p; int G, bid, l; lds8* lds;
  DI bool next(int ui, g8::Desc& d) const {
    const int L = ui * G + bid; int pm, pn;
    d.lda = 1024; d.ldb = 1024; d.nt = 16;
    if (L < 2860) { unit_next(130, 22, L, pm, pn); d.aux = 0; d.B = (const char*)(p.ws + OFF_WIN) + (size_t)pn * 256 * 1024 * 2; }
    else if (l == 0 && L < 2860 + 32) { const int e = L - 2860; pm = 128 + (e >> 4); pn = e & 15; d.aux = 1;
      d.B = (const char*)(p.ws + OFF_WIN) + (size_t)(5632 + pn * 256) * 1024 * 2; }
    else return false;
    d.A = (const char*)(p.ws + OFF_H) + (size_t)pm * 256 * 1024 * 2; d.pm = pm; d.pn = pn; return true; }
  DI void epi(const g8::Desc& d, const f32x4 (&acc)[2][2][4][2]) const {
    const int tid = launder_tid(), wid = tid >> 6, lane = tid & 63, wr = wid >> 2, wc = wid & 3, fr = lane & 15, fq = lane >> 4;
    bf16_t* PM = (bf16_t*)(p.ws + OFF_PM); bf16_t* Y = (bf16_t*)(p.ws + OFF_Y); bf16_t* VTD = (bf16_t*)(p.ws + OFF_VTD); bf16_t* VTB = (bf16_t*)(p.ws + OFF_VTB);
    const int cpm = d.pm, cpn = d.pn;
    if (d.aux == 1) {
      bf16_t* CG = (bf16_t*)(p.ws + OFF_CG);
#pragma unroll
      for (int ai = 0; ai < 2; ++ai)
#pragma unroll
        for (int m = 0; m < 4; ++m) { const int row = (cpm - 128) * 256 + ai * 128 + wr * 64 + m * 16 + fr;
#pragma unroll
          for (int bj = 0; bj < 2; ++bj)
#pragma unroll
            for (int n = 0; n < 2; ++n) { const int col = cpn * 256 + bj * 128 + wc * 32 + n * 16 + fq * 4; const f32x4 v = acc[ai][bj][m][n];
              u32x2 o; o.x = pk2(sigm(v[0]), sigm(v[1])); o.y = pk2(sigm(v[2]), sigm(v[3])); *(u32x2*)(CG + (size_t)row * 4096 + col) = o; } }
      return;
    }
    const bool kh0 = (cpn == 11 || cpn == 12), kh1 = (cpn == 3 || cpn == 11 || cpn == 12);
    LAS float* xch = (LAS float*)(lds + 131072);
    if (kh1) {
#pragma unroll
      for (int bj = 0; bj < 2; ++bj) if (bj == 1 || kh0) {
#pragma unroll
        for (int ai = 0; ai < 2; ++ai)
#pragma unroll
          for (int m = 0; m < 4; ++m) { const f32x4 a0 = acc[ai][bj][m][0], a1 = acc[ai][bj][m][1];
            float ss = a0[0] * a0[0] + a0[1] * a0[1] + a0[2] * a0[2] + a0[3] * a0[3] + a1[0] * a1[0] + a1[1] * a1[1] + a1[2] * a1[2] + a1[3] * a1[3];
            ss += shx<16>(ss); ss = sum32(ss);
            if (fq == 0) xch[(bj * 4 + wc) * 256 + ai * 128 + wr * 64 + m * 16 + fr] = ss; } }
      asm volatile("s_waitcnt lgkmcnt(0)" ::: "memory"); __builtin_amdgcn_s_barrier(); asm volatile("" ::: "memory");
    }
    const float* RT = (const float*)(p.ws + OFF_ROPE); const float* gain = (cpn == 3 ? p.k_norm_b : p.k_norm_d) + l * 64;
    const int hw = wc & 1;
#pragma unroll
    for (int bj = 0; bj < 2; ++bj) {
      const int colh = cpn * 256 + bj * 128;
      const bool khalf = bj == 1 ? kh1 : kh0;
      int mode, dcol, ld; bf16_t* dst;
      if (colh < 1024) { mode = 0; dst = PM; ld = LDPM; dcol = colh; }
      else if (colh < 1152) { mode = 1; dst = VTB; ld = 128; dcol = colh - 1024; }
      else if (colh < 3328) { mode = 0; dst = PM; ld = LDPM; dcol = colh - 128; }
      else if (colh < 3840) { mode = 1; dst = VTD; ld = 512; dcol = colh - 3328; }
      else { mode = 2; dst = Y; ld = LDY; dcol = colh - 3840; }
#pragma unroll
      for (int ai = 0; ai < 2; ++ai)
#pragma unroll
        for (int m = 0; m < 4; ++m) {
          const int rsl = ai * 128 + wr * 64 + m * 16 + fr; const int row = cpm * 256 + rsl;
          f32x4 v0 = acc[ai][bj][m][0], v1 = acc[ai][bj][m][1];
          const int c40 = dcol + wc * 32 + fq * 4, c41 = c40 + 16;
          if (mode == 1) {
            int b, key; if (row < TL) { b = row >> 14; key = 256 + (row & 16383); } else { b = (row - TL) >> 8; key = (row - TL) & 255; }
#pragma unroll
            for (int j = 0; j < 4; ++j) { dst[((size_t)(b * ld + c40 + j)) * NKEY + key] = f2bf(v0[j]); dst[((size_t)(b * ld + c41 + j)) * NKEY + key] = f2bf(v1[j]); }
          } else {
            if (mode == 2) { v0[0] = siluf(v0[0]); v0[1] = siluf(v0[1]); v0[2] = siluf(v0[2]); v0[3] = siluf(v0[3]); v1[0] = siluf(v1[0]); v1[1] = siluf(v1[1]); v1[2] = siluf(v1[2]); v1[3] = siluf(v1[3]); }
            if (khalf) {
              const float tot = xch[(bj * 4 + wc) * 256 + rsl] + xch[(bj * 4 + (wc ^ 1)) * 256 + rsl]; const float rs = rsqrtf(tot * (1.f / 64.f) + 1e-6f);
              const f32x4 g0 = *(const f32x4*)(gain + 32 * hw + 4 * fq), g1 = *(const f32x4*)(gain + 32 * hw + 16 + 4 * fq);
              v0 = v0 * rs * g0; v1 = v1 * rs * g1;
              if (cpm < 128) { const int ntok = row & 16383; const int pos = hw ? (ntok & 63) : (ntok >> 6);
                const f32x4* cp = (const f32x4*)(RT + 2 * (pos * 16 + 4 * fq)); const f32x4 c01 = cp[0], c23 = cp[1];
                const f32x4 cc = {c01[0], c01[2], c23[0], c23[2]}, sn = {c01[1], c01[3], c23[1], c23[3]};
                const f32x4 o0 = v0 * cc - v1 * sn, o1 = v1 * cc + v0 * sn; v0 = o0; v1 = o1; }
            }
            u32x2 o; o.x = pk2(v0[0], v0[1]); o.y = pk2(v0[2], v0[3]); *(u32x2*)(dst + (size_t)row * ld + c40) = o;
            o.x = pk2(v1[0], v1[1]); o.y = pk2(v1[2], v1[3]); *(u32x2*)(dst + (size_t)row * ld + c41) = o;
          }
        }
    }
  }
};
DI void phase_inproj(const Params& p, int l, lds8* lds) { InprojCtx c{p, (int)gridDim.x, (int)blockIdx.x, l, lds}; g8::gemm_stream(lds, c); }

DI u32x4 normrope_proc(const u32x4 raw, const f32x4 g0, const f32x4 g1, float scale, bool rope, const f32x2 (&cs)[8], float sgn) {
  float y[8]; y[0] = bflo(raw.x); y[1] = bfhi(raw.x); y[2] = bflo(raw.y); y[3] = bfhi(raw.y); y[4] = bflo(raw.z); y[5] = bfhi(raw.z); y[6] = bflo(raw.w); y[7] = bfhi(raw.w);
  float ss = 0.f;
#pragma unroll
  for (int e = 0; e < 8; ++e) ss += y[e] * y[e];
  ss += shx<1>(ss); ss += shx<2>(ss); ss += shx<4>(ss);
  const float rs = rsqrtf(ss * (1.f / 64.f) + 1e-6f);
  y[0] *= rs * g0[0]; y[1] *= rs * g0[1]; y[2] *= rs * g0[2]; y[3] *= rs * g0[3]; y[4] *= rs * g1[0]; y[5] *= rs * g1[1]; y[6] *= rs * g1[2]; y[7] *= rs * g1[3];
  if (rope) {
#pragma unroll
    for (int e = 0; e < 8; ++e) { const float yp = shx<2>(y[e]); y[e] = y[e] * cs[e].x + sgn * yp * cs[e].y; }
  }
  u32x4 o; o.x = pk2(y[0] * scale, y[1] * scale); o.y = pk2(y[2] * scale, y[3] * scale); o.z = pk2(y[4] * scale, y[5] * scale); o.w = pk2(y[6] * scale, y[7] * scale); return o;
}
DI void normrope_phase(const Params& p, int l, int w, int lane) {
  const float* RT = (const float*)(p.ws + OFF_ROPE);
  const int l8 = lane & 7, quarter = l8 >> 1; const float sgn = (quarter & 1) ? 1.f : -1.f; const bool a3 = lane < 16;
  const f32x4 gq0 = *(const f32x4*)(p.q_norm_b + l * 64 + l8 * 8), gq1 = *(const f32x4*)(p.q_norm_b + l * 64 + l8 * 8 + 4);
  const f32x4 gd0 = *(const f32x4*)(p.q_norm_d + l * 64 + l8 * 8), gd1 = *(const f32x4*)(p.q_norm_d + l * 64 + l8 * 8 + 4);
  const f32x4 gk0 = *(const f32x4*)(p.k_norm_d + l * 64 + l8 * 8), gk1 = *(const f32x4*)(p.k_norm_d + l * 64 + l8 * 8 + 4);
  const f32x4 gb0 = *(const f32x4*)(p.k_norm_b + l * 64 + l8 * 8), gb1 = *(const f32x4*)(p.k_norm_b + l * 64 + l8 * 8 + 4);
  for (int R = blockIdx.x * 8 + w; R < TT; R += gridDim.x * 8) {
    bf16_t* base = (bf16_t*)(p.ws + OFF_PM) + (size_t)R * LDPM + lane * 8;
    const bool rope = R < TL; const int n = R & 16383, prow = n >> 6, pcol = n & 63;
    const u32x4 r2 = *(const u32x4*)(base + PM_DK);
    u32x4 r3 = {0u, 0u, 0u, 0u}; if (a3) r3 = *(const u32x4*)(base + PM_BK);
    f32x2 cs[8];
    if (rope) { const int pos = quarter < 2 ? prow : pcol; const f32x4* cp = (const f32x4*)(RT + 2 * (pos * 16 + 8 * (l8 & 1)));
#pragma unroll
      for (int q = 0; q < 4; ++q) { const f32x4 c4 = cp[q]; cs[2 * q] = (f32x2){c4[0], c4[1]}; cs[2 * q + 1] = (f32x2){c4[2], c4[3]}; } }
    else {
#pragma unroll
      for (int e = 0; e < 8; ++e) cs[e] = (f32x2){1.f, 0.f}; }
    const u32x4 o2 = normrope_proc(r2, gk0, gk1, 1.f, rope, cs, sgn); *(u32x4*)(base + PM_DK) = o2;
    const u32x4 o3 = normrope_proc(r3, gb0, gb1, 1.f, rope, cs, sgn); if (a3) *(u32x4*)(base + PM_BK) = o3;
  }
}

DI void unpack8(const u32x4& r, float (&y)[8]) { y[0] = bflo(r.x); y[1] = bfhi(r.x); y[2] = bflo(r.y); y[3] = bfhi(r.y); y[4] = bflo(r.z); y[5] = bfhi(r.z); y[6] = bflo(r.w); y[7] = bfhi(r.w); }

DI void conv_item(const Params& p, int l, int item) {
  const bf16_t* PM = (const bf16_t*)(p.ws + OFF_PM); bf16_t* Y = (bf16_t*)(p.ws + OFF_Y);
  const int R = item / 48, ch = (item % 48) * 8;
  int n, N; if (R < TL) { n = R & 16383; N = 16384; } else { n = (R - TL) & 255; N = 256; }
  const float* cw = p.conv_w + l * 3 * 384 + ch;
  float conv[8];
#pragma unroll
  for (int e = 0; e < 8; ++e) conv[e] = 0.f;
#pragma unroll
  for (int j = 0; j < 3; ++j) { const int nn = n + j - 1; if (nn >= 0 && nn < N) {
      const size_t rr = (size_t)(R + j - 1) * LDPM; float xa[8], ca[8]; unpack8(*(const u32x4*)(PM + rr + PM_CX + ch), xa); unpack8(*(const u32x4*)(PM + rr + PM_CC + ch), ca);
      const f32x4 w0 = *(const f32x4*)(cw + j * 384), w1 = *(const f32x4*)(cw + j * 384 + 4);
      conv[0] += w0[0] * (xa[0] * ca[0]); conv[1] += w0[1] * (xa[1] * ca[1]); conv[2] += w0[2] * (xa[2] * ca[2]); conv[3] += w0[3] * (xa[3] * ca[3]);
      conv[4] += w1[0] * (xa[4] * ca[4]); conv[5] += w1[1] * (xa[5] * ca[5]); conv[6] += w1[2] * (xa[6] * ca[6]); conv[7] += w1[3] * (xa[7] * ca[7]); } }
  float ba[8], sz[8]; unpack8(*(const u32x4*)(PM + (size_t)R * LDPM + PM_CB + ch), ba);
  bf16_t* yp = Y + (size_t)R * LDY + Y_C + ch; unpack8(*(const u32x4*)yp, sz);
  u32x4 o; o.x = pk2(ba[0] * conv[0] * sz[0], ba[1] * conv[1] * sz[1]); o.y = pk2(ba[2] * conv[2] * sz[2], ba[3] * conv[3] * sz[3]);
  o.z = pk2(ba[4] * conv[4] * sz[4], ba[5] * conv[5] * sz[5]); o.w = pk2(ba[6] * conv[6] * sz[6], ba[7] * conv[7] * sz[7]); *(u32x4*)yp = o;
}

DI void fourierA_item(const Params& p, int b, int n2, int g) {
  const int tid = launder_tid(), lane = tid & 63, w = tid >> 6, r = lane & 31, hh = lane >> 5, mb = w & 1, kq = w >> 1;
  const bf16_t* PM = (const bf16_t*)(p.ws + OFF_PM); const bf16_t* WcT = (const bf16_t*)(p.ws + OFF_TAB);
  const bf16_t* CP = WcT + 8192; const bf16_t* SP = CP + 16384; const bf16_t* NSP = SP + 16384; bf16_t* AP = (bf16_t*)(p.ws + OFF_AP);
  bf16x8 wfr[2][4];
#pragma unroll
  for (int part = 0; part < 2; ++part)
#pragma unroll
    for (int s = 0; s < 4; ++s) wfr[part][s] = *(const bf16x8*)(WcT + (64 * part + 32 * mb + r) * 64 + 16 * s + 8 * hh);
  bf16x8 vf[4][2][2];
#pragma unroll
  for (int rb = 0; rb < 4; ++rb) {
    const size_t token = (size_t)b * 16384 + 128 * (32 * rb + r) + n2; bf16x8 uf[4];
#pragma unroll
    for (int s = 0; s < 4; ++s) uf[s] = *(const bf16x8*)(PM + token * LDPM + PM_AX + g * 64 + 16 * s + 8 * hh);
#pragma unroll
    for (int part = 0; part < 2; ++part) { f32x16 v = splat16(0.f);
#pragma unroll
      for (int s = 0; s < 4; ++s) v = MFMA32(uf[s], wfr[part][s], v);
      vf[rb][0][part] = pack8(v, 0); vf[rb][1][part] = pack8(v, 1); }
  }
  f32x16 Ar = splat16(0.f), Ai = splat16(0.f);
#pragma unroll
  for (int rb = 0; rb < 4; ++rb)
#pragma unroll
    for (int sx = 0; sx < 2; ++sx) { const int pos = (32 * kq + r) * 128 + 32 * rb + 16 * sx + 8 * hh;
      const bf16x8 cf = *(const bf16x8*)(CP + pos), sf = *(const bf16x8*)(SP + pos), nsf = *(const bf16x8*)(NSP + pos);
      Ar = MFMA32(cf, vf[rb][sx][0], Ar); Ar = MFMA32(sf, vf[rb][sx][1], Ar);
      Ai = MFMA32(cf, vf[rb][sx][1], Ai); Ai = MFMA32(nsf, vf[rb][sx][0], Ai); }
#pragma unroll
  for (int i = 0; i < 16; ++i) { const int k1 = 32 * kq + crow(i, hh); const float rev = (float)(n2 * k1) * (1.f / 16384.f); const float cs = cosrev(rev), sn = sinrev(rev);
    const float ar = Ar[i] * cs + Ai[i] * sn, ai = Ai[i] * cs - Ar[i] * sn;
    const size_t o = ((((size_t)b * 128 + k1) * 6 + g) * 128 + n2) * 128 + 32 * mb + r; AP[o] = f2bf(ar); AP[o + 64] = f2bf(ai); }
}

DI void fourierA_wave(const Params& p, int b, int n2, int g, int lane) {
  const int r = lane & 31, hh = lane >> 5;
  const bf16_t* PM = (const bf16_t*)(p.ws + OFF_PM); const bf16_t* WcT = (const bf16_t*)(p.ws + OFF_TAB);
  const bf16_t* CP = WcT + 8192; const bf16_t* SP = CP + 16384; const bf16_t* NSP = SP + 16384; bf16_t* AP = (bf16_t*)(p.ws + OFF_AP);
#pragma unroll 1
  for (int mb = 0; mb < 2; ++mb) {
    bf16x8 vf[4][2][2];
    { bf16x8 wfr[2][4];
#pragma unroll
      for (int part = 0; part < 2; ++part)
#pragma unroll
        for (int s = 0; s < 4; ++s) wfr[part][s] = *(const bf16x8*)(WcT + (64 * part + 32 * mb + r) * 64 + 16 * s + 8 * hh);
#pragma unroll
      for (int rb = 0; rb < 4; ++rb) { const size_t token = (size_t)b * 16384 + 128 * (32 * rb + r) + n2; bf16x8 uf[4];
#pragma unroll
        for (int s = 0; s < 4; ++s) uf[s] = *(const bf16x8*)(PM + token * LDPM + PM_AX + g * 64 + 16 * s + 8 * hh);
#pragma unroll
        for (int part = 0; part < 2; ++part) { f32x16 v = splat16(0.f);
#pragma unroll
          for (int s = 0; s < 4; ++s) v = MFMA32(uf[s], wfr[part][s], v);
          vf[rb][0][part] = pack8(v, 0); vf[rb][1][part] = pack8(v, 1); } } }
#pragma unroll 1
    for (int kq = 0; kq < 4; ++kq) {
      f32x16 Ar = splat16(0.f), Ai = splat16(0.f);
#pragma unroll
      for (int rb = 0; rb < 4; ++rb)
#pragma unroll
        for (int sx = 0; sx < 2; ++sx) { const int pos = (32 * kq + r) * 128 + 32 * rb + 16 * sx + 8 * hh;
          const bf16x8 cf = *(const bf16x8*)(CP + pos), sf = *(const bf16x8*)(SP + pos), nsf = *(const bf16x8*)(NSP + pos);
          Ar = MFMA32(cf, vf[rb][sx][0], Ar); Ar = MFMA32(sf, vf[rb][sx][1], Ar);
          Ai = MFMA32(cf, vf[rb][sx][1], Ai); Ai = MFMA32(nsf, vf[rb][sx][0], Ai); }
#pragma unroll
      for (int i = 0; i < 16; ++i) { const int k1 = 32 * kq + crow(i, hh); const float rev = (float)(n2 * k1) * (1.f / 16384.f); const float cs = cosrev(rev), sn = sinrev(rev);
        const float ar = Ar[i] * cs + Ai[i] * sn, ai = Ai[i] * cs - Ar[i] * sn;
        const size_t o = ((((size_t)b * 128 + k1) * 6 + g) * 128 + n2) * 128 + 32 * mb + r; AP[o] = f2bf(ar); AP[o + 64] = f2bf(ai); }
    }
  }
}

DI void fourierB_item(const Params& p, int b, int k1, int g, lds8* lds) {
  const int tid = launder_tid(), lane = tid & 63, w = tid >> 6, r = lane & 31, hh = lane >> 5, mb = w & 1, kq = w >> 1;
  const bf16_t* X = (const bf16_t*)(p.ws + OFF_AP) + (((size_t)b * 128 + k1) * 6 + g) * 16384;
  const bf16_t* CN = (const bf16_t*)(p.ws + OFF_TAB) + 8192 + 3 * 16384; const bf16_t* SN = CN + 16384; bf16_t* Y = (bf16_t*)(p.ws + OFF_Y);
#pragma unroll
  for (int i = 0; i < 4; ++i) { const int e = tid + NT * i, row = e >> 4, ch = e & 15; *(LAS u32x4*)(lds + row * 272 + ch * 16) = *(const u32x4*)(X + row * 128 + ch * 8); }
  __syncthreads();
  f32x16 F = splat16(0.f);
#pragma unroll
  for (int s = 0; s < 8; ++s) {
    const bf16x8 cf = *(const bf16x8*)(CN + (32 * kq + r) * 128 + 16 * s + 8 * hh), sf = *(const bf16x8*)(SN + (32 * kq + r) * 128 + 16 * s + 8 * hh);
    bf16x8 xr, xi;
#pragma unroll
    for (int j = 0; j < 8; ++j) { const int row = 16 * s + 8 * hh + j; xr[j] = *(const LAS short*)(lds + row * 272 + (32 * mb + r) * 2); xi[j] = *(const LAS short*)(lds + row * 272 + (64 + 32 * mb + r) * 2); }
    F = MFMA32(cf, xr, F); F = MFMA32(sf, xi, F);
  }
#pragma unroll
  for (int i = 0; i < 16; ++i) { const int k2 = 32 * kq + crow(i, hh); const size_t idx = ((size_t)b * 16384 + k1 + 128 * k2) * LDY + Y_A + g * 64 + 32 * mb + r;
    Y[idx] = f2bf(F[i] * (1.f / 1024.f) * bf2f(Y[idx])); }
  __syncthreads();
}

DI void fourierB_wave(const Params& p, int b, int k1, int g, int mb, int w, int lane, lds8* lds) {
  const int r = lane & 31, hh = lane >> 5;
  const bf16_t* X = (const bf16_t*)(p.ws + OFF_AP) + (((size_t)b * 128 + k1) * 6 + g) * 16384;
  const bf16_t* CN = (const bf16_t*)(p.ws + OFF_TAB) + 8192 + 3 * 16384; const bf16_t* SN = CN + 16384; bf16_t* Y = (bf16_t*)(p.ws + OFF_Y);
  lds8* slab = lds + w * 17408;
#pragma unroll
  for (int i = 0; i < 16; ++i) { const int e = lane + 64 * i, row = e >> 3, c = e & 7;
    const u32x4 v = *(const u32x4*)(X + row * 128 + (c < 4 ? 32 * mb + c * 8 : 64 + 32 * mb + (c - 4) * 8));
    *(LAS u32x2*)(slab + row * 136 + c * 16) = (u32x2){v.x, v.y}; *(LAS u32x2*)(slab + row * 136 + c * 16 + 8) = (u32x2){v.z, v.w}; }
  bf16x8 xr[8], xi[8];
#pragma unroll
  for (int s = 0; s < 8; ++s)
#pragma unroll
    for (int j = 0; j < 8; ++j) { const int row = 16 * s + 8 * hh + j; xr[s][j] = *(const LAS short*)(slab + row * 136 + r * 2); xi[s][j] = *(const LAS short*)(slab + row * 136 + 64 + r * 2); }
#pragma unroll 1
  for (int kq = 0; kq < 4; ++kq) {
    f32x16 F = splat16(0.f);
#pragma unroll
    for (int s = 0; s < 8; ++s) {
      const bf16x8 cf = *(const bf16x8*)(CN + (32 * kq + r) * 128 + 16 * s + 8 * hh), sf = *(const bf16x8*)(SN + (32 * kq + r) * 128 + 16 * s + 8 * hh);
      F = MFMA32(cf, xr[s], F); F = MFMA32(sf, xi[s], F); }
#pragma unroll
    for (int i = 0; i < 16; ++i) { const int k2 = 32 * kq + crow(i, hh); const size_t idx = ((size_t)b * 16384 + k1 + 128 * k2) * LDY + Y_A + g * 64 + 32 * mb + r;
      Y[idx] = f2bf(F[i] * (1.f / 1024.f) * bf2f(Y[idx])); }
  }
}

DI void fourierC_item(const Params& p, int b, int g, int kc, lds8* lds) {
  const int tid = launder_tid();
  LAS float* V = (LAS float*)lds; LAS float* T64c = V + 32768; LAS float* T64s = T64c + 64; LAS float* T256c = T64s + 64; LAS float* T256s = T256c + 256;
  const bf16_t* PM = (const bf16_t*)(p.ws + OFF_PM); bf16_t* Y = (bf16_t*)(p.ws + OFF_Y);
  if (tid < 64) { T64c[tid] = cosrev((float)tid * (1.f / 64.f)); T64s[tid] = sinrev((float)tid * (1.f / 64.f)); }
  if (tid < 256) { T256c[tid] = cosrev((float)tid * (1.f / 256.f)); T256s[tid] = sinrev((float)tid * (1.f / 256.f)); }
  __syncthreads();
  for (int e = tid; e < 32768; e += NT) { const int n = e >> 7, mp = e & 127, m = mp & 63;
    const bf16_t* up = PM + (size_t)(TL + b * 256 + n) * LDPM + PM_AX + g * 64; float a = 0.f;
    for (int c8 = 0; c8 < 64; c8 += 8) { float u[8]; unpack8(*(const u32x4*)(up + c8), u);
#pragma unroll
      for (int j = 0; j < 8; ++j) { const int t = (m * (c8 + j)) & 63; a += u[j] * (mp < 64 ? T64c[t] : -T64s[t]); } }
    V[e] = a; }
  __syncthreads();
#pragma unroll
  for (int i = 0; i < 4; ++i) { const int e = tid + NT * i; const int k = kc * 32 + (e >> 6), m = e & 63; float a = 0.f;
    for (int n = 0; n < 256; ++n) { const int t = (k * n) & 255; a += T256c[t] * V[n * 128 + m] + T256s[t] * V[n * 128 + 64 + m]; }
    const size_t idx = (size_t)(TL + b * 256 + k) * LDY + Y_A + g * 64 + m; Y[idx] = f2bf(a * (1.f / 128.f) * bf2f(Y[idx])); }
  __syncthreads();
}

DI void fourierC_stage1(const Params& p, lds8* lds) {
  const int tid = launder_tid(); LAS float* T = (LAS float*)lds;
  const bf16_t* PM = (const bf16_t*)(p.ws + OFF_PM); float* VC = (float*)(p.ws + OFF_VC);
  __syncthreads();
  if (tid < 64) { T[tid] = cosrev((float)tid * (1.f / 64.f)); T[64 + tid] = sinrev((float)tid * (1.f / 64.f)); }
  __syncthreads();
  for (int e = blockIdx.x * NT + tid; e < 2 * 256 * 6 * 128; e += gridDim.x * NT) {
    const int mp = e & 127, g = (e >> 7) % 6, n = (e / 768) & 255, b = e / (768 * 256), m = mp & 63;
    const bf16_t* up = PM + (size_t)(TL + b * 256 + n) * LDPM + PM_AX + g * 64; float a = 0.f;
    for (int c8 = 0; c8 < 64; c8 += 8) { float u[8]; unpack8(*(const u32x4*)(up + c8), u);
#pragma unroll
      for (int j = 0; j < 8; ++j) { const int t = (m * (c8 + j)) & 63; a += u[j] * (mp < 64 ? T[t] : -T[64 + t]); } }
    VC[e] = a; }
  __syncthreads();
}
DI void fourierC_stage2(const Params& p, lds8* lds) {
  const int tid = launder_tid(); LAS float* T = (LAS float*)lds;
  const float* VC = (const float*)(p.ws + OFF_VC); bf16_t* Y = (bf16_t*)(p.ws + OFF_Y);
  __syncthreads();
  if (tid < 256) { T[tid] = cosrev((float)tid * (1.f / 256.f)); T[256 + tid] = sinrev((float)tid * (1.f / 256.f)); }
  __syncthreads();
  for (int e = blockIdx.x * NT + tid; e < 2 * 256 * 6 * 64; e += gridDim.x * NT) {
    const int m = e & 63, g = (e >> 6) % 6, k = (e / 384) & 255, b = e / (384 * 256);
    const float* vp = VC + ((size_t)(b * 256) * 6 + g) * 128 + m; float a = 0.f;
#pragma unroll 8
    for (int n = 0; n < 256; ++n) { const int t = (k * n) & 255; a += T[t] * vp[(size_t)n * 768] + T[256 + t] * vp[(size_t)n * 768 + 64]; }
    const size_t idx = (size_t)(TL + b * 256 + k) * LDY + Y_A + g * 64 + m; Y[idx] = f2bf(a * (1.f / 128.f) * bf2f(Y[idx])); }
  __syncthreads();
}

DI void q_prep(bf16x8 (&qf)[4], const float* __restrict__ gain, bool rope, int prow, int pcol, int hh, const float* __restrict__ RT) {
  float y[4][8]; float ss = 0.f;
#pragma unroll
  for (int s = 0; s < 4; ++s)
#pragma unroll
    for (int j = 0; j < 8; ++j) { y[s][j] = bf2f((bf16_t)qf[s][j]); ss += y[s][j] * y[s][j]; }
  ss = sum32(ss);
  const float rs = rsqrtf(ss * (1.f / 64.f) + 1e-6f);
#pragma unroll
  for (int s = 0; s < 4; ++s) { const f32x4 g0 = *(const f32x4*)(gain + 16 * s + 8 * hh), g1 = *(const f32x4*)(gain + 16 * s + 8 * hh + 4);
    y[s][0] *= rs * g0[0]; y[s][1] *= rs * g0[1]; y[s][2] *= rs * g0[2]; y[s][3] *= rs * g0[3]; y[s][4] *= rs * g1[0]; y[s][5] *= rs * g1[1]; y[s][6] *= rs * g1[2]; y[s][7] *= rs * g1[3]; }
  if (rope) {
    const f32x4* cr = (const f32x4*)(RT + 2 * (prow * 16 + 8 * hh)); const f32x4* cc = (const f32x4*)(RT + 2 * (pcol * 16 + 8 * hh));
#pragma unroll
    for (int q = 0; q < 4; ++q) { const f32x4 a4 = cr[q], b4 = cc[q];
#pragma unroll
      for (int e = 0; e < 2; ++e) { const int jj = 2 * q + e; const float c1 = a4[2 * e], s1 = a4[2 * e + 1], c2 = b4[2 * e], s2 = b4[2 * e + 1];
        const float t1 = y[0][jj], t2 = y[1][jj], t3 = y[2][jj], t4 = y[3][jj];
        y[0][jj] = t1 * c1 - t2 * s1; y[1][jj] = t2 * c1 + t1 * s1; y[2][jj] = t3 * c2 - t4 * s2; y[3][jj] = t4 * c2 + t3 * s2; } }
  }
#pragma unroll
  for (int s = 0; s < 4; ++s) { u32x4 w; w.x = pk2(y[s][0] * QSCALE, y[s][1] * QSCALE); w.y = pk2(y[s][2] * QSCALE, y[s][3] * QSCALE); w.z = pk2(y[s][4] * QSCALE, y[s][5] * QSCALE); w.w = pk2(y[s][6] * QSCALE, y[s][7] * QSCALE);
    qf[s] = __builtin_bit_cast(bf16x8, w); }
}

constexpr int KP = 144;
template <int NDB>
DI void attn_tile(const lds8* kb_, const lds8* vb_, const bf16x8 (&qf)[4], f32x16 (&O)[NDB], float& lsum, float negM, int mmode, int qi, int koff, int r, int pr, int hh) {
  f32x16 S[2];
#pragma unroll
  for (int kb = 0; kb < 2; ++kb) { S[kb] = splat16(negM);
#pragma unroll
    for (int s = 0; s < 4; ++s) { const bf16x8 kf = *(const LAS bf16x8*)(kb_ + (32 * kb + pr) * KP + (16 * s + 8 * hh) * 2); S[kb] = MFMA32(kf, qf[s], S[kb]); } }
  if (mmode != 0) {
#pragma unroll
    for (int kb = 0; kb < 2; ++kb)
#pragma unroll
      for (int i = 0; i < 16; ++i) { const int kj = koff + 32 * kb + 16 * (i >> 3) + 8 * hh + (i & 7); const bool ok = mmode == 1 ? (kj >= qi) : (kj <= qi); if (!ok) S[kb][i] = -1e30f; }
  }
#pragma unroll
  for (int kb = 0; kb < 2; ++kb)
#pragma unroll
    for (int i = 0; i < 16; ++i) { const float pv = __builtin_amdgcn_exp2f(S[kb][i]); lsum += pv; S[kb][i] = pv; }
#pragma unroll
  for (int kb = 0; kb < 2; ++kb)
#pragma unroll
    for (int s = 0; s < 2; ++s) { const bf16x8 pf = pack8(S[kb], s);
#pragma unroll
      for (int db = 0; db < NDB; ++db) { const bf16x8 vfr = *(const LAS bf16x8*)(vb_ + (32 * db + r) * KP + (32 * kb + 16 * s + 8 * hh) * 2); O[db] = MFMA32(vfr, pf, O[db]); } }
}

DI float gain_max(const float* g, int lane) { float v = fabsf(g[lane]);
  v = wave_max(v);
  return v; }

constexpr int DSTG = 65536;
DI void attn_diff_item(const Params& p, int l, int b, int h, int qb, bool ctxq, lds8* lds) {
  const int tid = launder_tid(), lane = tid & 63, w = tid >> 6, r = lane & 31, hh = lane >> 5;
  const int pr = (r & ~12) | ((r & 4) << 1) | ((r & 8) >> 1);
  const bf16_t* PM = (const bf16_t*)(p.ws + OFF_PM); const bf16_t* VTD = (const bf16_t*)(p.ws + OFF_VTD); bf16_t* Y = (bf16_t*)(p.ws + OFF_Y);
  const size_t qrow = (size_t)(ctxq ? TL + b * 256 : b * 16384) + qb * 256 + w * 32 + r;
  bf16x8 qf[2][4];
#pragma unroll
  for (int c = 0; c < 2; ++c)
#pragma unroll
    for (int s = 0; s < 4; ++s) qf[c][s] = *(const bf16x8*)(PM + qrow * LDPM + PM_DQ + h * 128 + c * 64 + 16 * s + 8 * hh);
  { const int nq = (int)qrow & 16383; const float* RTq = (const float*)(p.ws + OFF_ROPE);
    q_prep(qf[0], p.q_norm_d + l * 64, !ctxq, nq >> 6, nq & 63, hh, RTq); q_prep(qf[1], p.q_norm_d + l * 64, !ctxq, nq >> 6, nq & 63, hh, RTq); }
  f32x16 O1[4], O2[4];
#pragma unroll
  for (int d = 0; d < 4; ++d) { O1[d] = splat16(0.f); O2[d] = splat16(0.f); }
  float ls1 = 0.f, ls2 = 0.f;
  const int nt = ctxq ? 2 : 130;
  const char* kbu = (const char*)(PM + (size_t)(TL + b * 256) * LDPM + PM_DK + h * 128);
  const char* kbu_lat = (const char*)(PM + (size_t)(b * 16384) * LDPM + PM_DK + h * 128);
  const char* vbu = (const char*)(VTD + (size_t)(b * 4 + h) * 128 * NKEY);
#define DSTAGE(buf_) do { const int t_ = launder_tid(); const int lr_ = t_ >> 3, lc_ = (t_ & 7) ^ ((lr_ >> 1) & 7), vr_ = t_ >> 4, vc_ = (t_ & 15) ^ (vr_ & 15); \
    const unsigned kvo = (unsigned)((lr_ * LDPM + lc_ * 8) * 2), vvo = (unsigned)((vr_ * NKEY + vc_ * 8) * 2); lds8* b__ = lds + t_ * 16 + (buf_) * DSTG; \
    __builtin_amdgcn_global_load_lds((const unsigned*)(kbu + kvo), (LAS unsigned*)b__, 16, 0, 0); __builtin_amdgcn_sched_barrier(0); \
    __builtin_amdgcn_global_load_lds((const unsigned*)(kbu + (size_t)64 * LDPM * 2 + kvo), (LAS unsigned*)(b__ + 8192), 16, 0, 0); __builtin_amdgcn_sched_barrier(0); \
    __builtin_amdgcn_global_load_lds((const unsigned*)(kbu + 128 + kvo), (LAS unsigned*)(b__ + 16384), 16, 0, 0); __builtin_amdgcn_sched_barrier(0); \
    __builtin_amdgcn_global_load_lds((const unsigned*)(kbu + (size_t)64 * LDPM * 2 + 128 + kvo), (LAS unsigned*)(b__ + 24576), 16, 0, 0); __builtin_amdgcn_sched_barrier(0); \
    __builtin_amdgcn_global_load_lds((const unsigned*)(vbu + vvo), (LAS unsigned*)(b__ + 32768), 16, 0, 0); __builtin_amdgcn_sched_barrier(0); \
    __builtin_amdgcn_global_load_lds((const unsigned*)(vbu + (size_t)32 * NKEY * 2 + vvo), (LAS unsigned*)(b__ + 40960), 16, 0, 0); __builtin_amdgcn_sched_barrier(0); \
    __builtin_amdgcn_global_load_lds((const unsigned*)(vbu + (size_t)64 * NKEY * 2 + vvo), (LAS unsigned*)(b__ + 49152), 16, 0, 0); __builtin_amdgcn_sched_barrier(0); \
    __builtin_amdgcn_global_load_lds((const unsigned*)(vbu + (size_t)96 * NKEY * 2 + vvo), (LAS unsigned*)(b__ + 57344), 16, 0, 0); __builtin_amdgcn_sched_barrier(0); \
    kbu += (size_t)128 * LDPM * 2; vbu += 256; } while (0)
  const int ksw = (pr >> 1) & 7, vsw = r & 15;
  int koff[4], voff[2];
#pragma unroll
  for (int s = 0; s < 4; ++s) koff[s] = pr * 128 + (((2 * s + hh) ^ ksw) << 4);
#pragma unroll
  for (int s = 0; s < 2; ++s) voff[s] = r * 256 + (((2 * s + hh) ^ vsw) << 4);
#define DBODY(cur_) do { \
    _Pragma("unroll 1") for (int kb = 0; kb < 4; ++kb) { \
      __builtin_amdgcn_iglp_opt(0); \
      bf16x8 P1[2], P2[2]; \
      _Pragma("unroll") for (int c = 0; c < 2; ++c) { \
        f32x16 S = splat16(0.f); \
        _Pragma("unroll") for (int s = 0; s < 4; ++s) { const bf16x8 kf = *(const LAS bf16x8*)(lds + c * 16384 + kb * 4096 + koff[s]); S = MFMA32(kf, qf[c][s], S); } \
        float ls = 0.f; \
        _Pragma("unroll") for (int i = 0; i < 16; ++i) { const float pv = __builtin_amdgcn_exp2f(S[i]); ls += pv; S[i] = pv; } \
        if (c == 0) { ls1 += ls; P1[0] = pack8(S, 0); P1[1] = pack8(S, 1); } else { ls2 += ls; P2[0] = pack8(S, 0); P2[1] = pack8(S, 1); } \
      } \
      _Pragma("unroll") for (int s = 0; s < 2; ++s) { \
        _Pragma("unroll") for (int db = 0; db < 4; ++db) { const bf16x8 vfr = *(const LAS bf16x8*)(lds + 32768 + db * 8192 + (voff[s] ^ (kb << 6))); \
          O1[db] = MFMA32(vfr, P1[s], O1[db]); O2[db] = MFMA32(vfr, P2[s], O2[db]); } } \
    } \
    _Pragma("unroll") for (int s = 0; s < 4; ++s) { koff[s] ^= DSTG; asm volatile("" : "+v"(koff[s])); } \
    _Pragma("unroll") for (int s = 0; s < 2; ++s) { voff[s] ^= DSTG; asm volatile("" : "+v"(voff[s])); } \
  } while (0)
  DSTAGE(0);
  asm volatile("s_waitcnt vmcnt(0)" ::: "memory"); __syncthreads();
#pragma unroll 1
  for (int t = 0; t < nt; t += 2) {
    DSTAGE(1);
    if (t + 2 == 2) kbu = kbu_lat;
    DBODY(0);
    asm volatile("s_waitcnt vmcnt(0)" ::: "memory"); __syncthreads();
    if (t + 2 < nt) DSTAGE(0);
    DBODY(1);
    asm volatile("s_waitcnt vmcnt(0)" ::: "memory"); __syncthreads();
  }
#undef DSTAGE
#undef DBODY
  const int tid2 = launder_tid(), lane2 = tid2 & 63, w2 = tid2 >> 6, r2 = lane2 & 31, hh2 = lane2 >> 5;
  const size_t qrow2 = (size_t)(ctxq ? TL + b * 256 : b * 16384) + qb * 256 + w2 * 32 + r2;
  ls1 = sum32(ls1); ls2 = sum32(ls2);
  float la = p.lam_q1[l * 64 + lane2] * p.lam_k1[l * 64 + lane2], lb = p.lam_q2[l * 64 + lane2] * p.lam_k2[l * 64 + lane2];
  la = wave_sum(la); lb = wave_sum(lb);
  const float lam_init = l == 0 ? 0.2f : (0.8f - 0.6f * 0.7408182206817179f);
  const float lam = __expf(la) - __expf(lb) + lam_init;
  const float i1 = 1.f / ls1, i2 = lam / ls2;
  float ss = 0.f;
#pragma unroll
  for (int d = 0; d < 4; ++d)
#pragma unroll
    for (int i = 0; i < 16; ++i) { const float o = O1[d][i] * i1 - O2[d][i] * i2; O1[d][i] = o; ss += o * o; }
  ss = sum32(ss);
  const float rs = rsqrtf(ss * (1.f / 128.f) + 1e-6f) * (1.f - lam_init);
  const float* sg = p.subln_d + l * 128;
  bf16_t* yrow = (bf16_t*)(p.ws + OFF_Y) + qrow2 * LDY + Y_D + h * 128;
#pragma unroll
  for (int d = 0; d < 4; ++d)
#pragma unroll
    for (int a = 0; a < 4; ++a) { const int dv = 32 * d + 8 * a + 4 * hh2; const u32x2 szr = *(const u32x2*)(yrow + dv); const f32x4 g4 = *(const f32x4*)(sg + dv);
      u32x2 o; o.x = pk2(O1[d][4 * a + 0] * rs * g4[0] * bflo(szr.x), O1[d][4 * a + 1] * rs * g4[1] * bfhi(szr.x));
      o.y = pk2(O1[d][4 * a + 2] * rs * g4[2] * bflo(szr.y), O1[d][4 * a + 3] * rs * g4[3] * bfhi(szr.y)); *(u32x2*)(yrow + dv) = o; }
  __syncthreads();
}

constexpr int SSTG = 18432;
DI void attn_swa_item(const Params& p, int l, int b, int hk, int blk, bool ctxq, lds8* lds) {
  const int tid = launder_tid(), lane = tid & 63, w = tid >> 6, r = lane & 31, hh = lane >> 5, rg = w & 3, hp = w >> 2;
  const int pr = (r & ~12) | ((r & 4) << 1) | ((r & 8) >> 1);
  const bf16_t* PM = (const bf16_t*)(p.ws + OFF_PM); const bf16_t* VTB = (const bf16_t*)(p.ws + OFF_VTB); bf16_t* Y = (bf16_t*)(p.ws + OFF_Y);
  constexpr float negM = 0.f;
  const size_t qrow = (size_t)(ctxq ? TL + b * 256 : b * 16384) + blk * 128 + rg * 32 + r;
  const int qi = rg * 32 + r;
  const int lrow = tid >> 3, lch = tid & 7;
  const bf16_t* vbase = VTB + ((size_t)(b * 2 + hk) * 64 + lrow) * NKEY + lch * 8;
  const int nt = ctxq ? 4 : 10;
  {
    const int hq = hk * 4 + hp * 2;
    bf16x8 qf0[4], qf1[4];
#pragma unroll
    for (int s = 0; s < 4; ++s) { qf0[s] = *(const bf16x8*)(PM + qrow * LDPM + PM_BQ + hq * 64 + 16 * s + 8 * hh); qf1[s] = *(const bf16x8*)(PM + qrow * LDPM + PM_BQ + (hq + 1) * 64 + 16 * s + 8 * hh); }
    { const int nq = (int)qrow & 16383; const float* RTq = (const float*)(p.ws + OFF_ROPE);
      q_prep(qf0, p.q_norm_b + l * 64, !ctxq, nq >> 6, nq & 63, hh, RTq); q_prep(qf1, p.q_norm_b + l * 64, !ctxq, nq >> 6, nq & 63, hh, RTq); }
    f32x16 O0[2], O1[2]; O0[0] = splat16(0.f); O0[1] = splat16(0.f); O1[0] = splat16(0.f); O1[1] = splat16(0.f);
    float ls0 = 0.f, ls1 = 0.f;
#define SWA_VALID(t_) ((t_) < 4 || (t_) == 6 || (t_) == 7 || ((t_) < 6 ? blk > 0 : blk < 127))
#define SWA_LOAD(t_) do { const int t__ = (t_); int krow0, key0; \
      if (t__ < 4) { krow0 = TL + b * 256 + t__ * 64; key0 = t__ * 64; } \
      else { const int bb = blk + ((t__ - 4) >> 1) - 1; const int nn = bb * 128 + ((t__ - 4) & 1) * 64; krow0 = b * 16384 + nn; key0 = 256 + nn; } \
      st0 = *(const u32x4*)(PM + (size_t)(krow0 + lrow) * LDPM + PM_BK + hk * 64 + lch * 8); st1 = *(const u32x4*)(vbase + key0); } while (0)
    u32x4 st0, st1; int t = 0, cur = 0;
    SWA_LOAD(0);
#pragma unroll 1
    while (t < nt) {
      lds8* bb_ = lds + cur * SSTG;
      *(LAS u32x4*)(bb_ + lrow * KP + lch * 16) = st0; *(LAS u32x4*)(bb_ + 9216 + lrow * KP + lch * 16) = st1;
      __syncthreads();
      int tn = t + 1; while (tn < nt && !SWA_VALID(tn)) ++tn;
      if (tn < nt) SWA_LOAD(tn);
      const int mmode = t < 4 ? 0 : (t < 6 ? 1 : (t < 8 ? 0 : 2)); const int koff = t < 4 ? 0 : ((t - 4) & 1) * 64;
      attn_tile<2>(bb_, bb_ + 9216, qf0, O0, ls0, negM, mmode, qi, koff, r, pr, hh);
      __builtin_amdgcn_sched_barrier(0);
      attn_tile<2>(bb_, bb_ + 9216, qf1, O1, ls1, negM, mmode, qi, koff, r, pr, hh);
      __builtin_amdgcn_sched_barrier(0);
      cur ^= 1; t = tn;
    }
#undef SWA_VALID
#undef SWA_LOAD
    ls0 = sum32(ls0); ls1 = sum32(ls1);
    ls0 += __builtin_amdgcn_exp2f(p.sink_b[l * 8 + hq] * LOG2E); ls1 += __builtin_amdgcn_exp2f(p.sink_b[l * 8 + hq + 1] * LOG2E);
    const float i0 = 1.f / ls0, i1 = 1.f / ls1;
    bf16_t* yrow = Y + qrow * LDY + Y_B + hq * 64;
#pragma unroll
    for (int d = 0; d < 2; ++d)
#pragma unroll
      for (int a = 0; a < 4; ++a) { const int dv = 32 * d + 8 * a + 4 * hh;
        { const u32x2 szr = *(const u32x2*)(yrow + dv); u32x2 o; o.x = pk2(O0[d][4 * a + 0] * i0 * bflo(szr.x), O0[d][4 * a + 1] * i0 * bfhi(szr.x)); o.y = pk2(O0[d][4 * a + 2] * i0 * bflo(szr.y), O0[d][4 * a + 3] * i0 * bfhi(szr.y)); *(u32x2*)(yrow + dv) = o; }
        { const u32x2 szr = *(const u32x2*)(yrow + 64 + dv); u32x2 o; o.x = pk2(O1[d][4 * a + 0] * i1 * bflo(szr.x), O1[d][4 * a + 1] * i1 * bfhi(szr.x)); o.y = pk2(O1[d][4 * a + 2] * i1 * bflo(szr.y), O1[d][4 * a + 3] * i1 * bfhi(szr.y)); *(u32x2*)(yrow + 64 + dv) = o; } }
    __syncthreads();
  }
}

DI void phase_elem(const Params& p, int l, lds8* lds) {
  const int tid = launder_tid(), lane = tid & 63, w = tid >> 6;
  normrope_phase(p, l, w, lane);
  for (int it = blockIdx.x * NT + tid; it < TT * 48; it += gridDim.x * NT) conv_item(p, l, it);
  for (int it = blockIdx.x; it < 1536; it += gridDim.x) { const int g = it % 6, n2 = (it / 6) % 128, b = it / 768; fourierA_item(p, b, n2, g); }
  if (l == 0) for (int it = blockIdx.x; it < 96; it += gridDim.x) { const int kc = it & 7, g = (it >> 3) % 6, b = it / 48; fourierC_item(p, b, g, kc, lds); }
}

DI void phase_mix(const Params& p, int l, lds8* lds) {
  for (int it = blockIdx.x; it < 512; it += gridDim.x) { const int bh = it & 7, qb = it >> 3; attn_diff_item(p, l, bh >> 2, bh & 3, qb, false, lds); }
  for (int it = blockIdx.x; it < 512; it += gridDim.x) { const int bk = it & 3, blk = it >> 2; attn_swa_item(p, l, bk >> 1, bk & 1, blk, false, lds); }
  for (int it = blockIdx.x; it < 1536; it += gridDim.x) { const int g = it % 6, k1 = (it / 6) % 128, b = it / 768; fourierB_item(p, b, k1, g, lds); }
  if (l == 0) {
    for (int it = blockIdx.x; it < 8; it += gridDim.x) { const int bh = it & 7; attn_diff_item(p, l, bh >> 2, bh & 3, 0, true, lds); }
    for (int it = blockIdx.x; it < 8; it += gridDim.x) { const int bk = it & 3, blk = it >> 2; attn_swa_item(p, l, bk >> 1, bk & 1, blk, true, lds); }
  }
}

struct GateCtx {
  const Params& p; int G, bid, l;
  int u, sub;
  DI bool next(int, g8::Desc& d) {
    int pm, pn; bool ctx = false;
    if (u < 2) unit_next(128, 4, u * G + bid, pm, pn);
    else return false;
    const int br = sub >> 1;
    d.pm = pm; d.pn = pn; d.aux = sub | (ctx ? 8 : 0);
    if ((sub & 1) == 0) { d.A = (const char*)(p.ws + OFF_H) + (size_t)pm * 256 * 1024 * 2; d.B = (const char*)(p.ws + OFF_WIN) + (size_t)(5632 + br * 1024 + pn * 256) * 1024 * 2; d.lda = 1024; d.ldb = 1024; d.nt = 16; }
    else { const int Kb = (br & 1) ? 512 : 384; const int ycol = br == 0 ? Y_A : (br == 1 ? Y_B : (br == 2 ? Y_C : Y_D));
      const size_t wooff = br == 0 ? 0 : (br == 1 ? 393216 : (br == 2 ? 917504 : 1310720));
      d.A = (const char*)(p.ws + OFF_Y) + ((size_t)pm * 256 * LDY + ycol) * 2; d.B = (const char*)(p.ws + OFF_WO) + (wooff + (size_t)pn * 256 * Kb) * 2; d.lda = LDY; d.ldb = Kb; d.nt = Kb / 64; }
    sub += ctx ? 2 : 1; if (sub >= 8) { sub = 0; ++u; }
    return true; }
  DI void epi(const g8::Desc& d, const f32x4 (&acc)[2][2][4][2]) const {
    const int tid2 = launder_tid();
    u32x2* SGt = (u32x2*)(p.ws + OFF_SCR + (size_t)bid * 393216) + tid2; u32x2* SMt = (u32x2*)(p.ws + OFF_SCR + (size_t)bid * 393216 + 131072) + tid2;
    const int br = (d.aux & 7) >> 1; const bool ctxg = (d.aux & 8) != 0;
    if ((d.aux & 1) == 0) {
#pragma unroll
      for (int ai = 0; ai < 2; ++ai)
#pragma unroll
        for (int bj = 0; bj < 2; ++bj)
#pragma unroll
          for (int m = 0; m < 4; ++m)
#pragma unroll
            for (int n = 0; n < 2; ++n) { const int slot = ((ai * 2 + bj) * 4 + m) * 2 + n; const f32x4 v = acc[ai][bj][m][n];
              u32x2 o; o.x = pk2(sigm(v[0]), sigm(v[1])); o.y = pk2(sigm(v[2]), sigm(v[3])); SGt[slot * NT] = o; }
    } else {
      bf16_t* MIXED = (bf16_t*)(p.ws + OFF_MIXED);
      const int wid2 = tid2 >> 6, lane2 = tid2 & 63, wr2 = wid2 >> 2, wc2 = wid2 & 3, fr2 = lane2 & 15, fq2 = lane2 >> 4;
#pragma unroll
      for (int ai = 0; ai < 2; ++ai)
#pragma unroll
        for (int bj = 0; bj < 2; ++bj)
#pragma unroll
          for (int m = 0; m < 4; ++m)
#pragma unroll
            for (int n = 0; n < 2; ++n) { const int slot = ((ai * 2 + bj) * 4 + m) * 2 + n; const f32x4 v = acc[ai][bj][m][n];
              const int row_ = d.pm * 256 + ai * 128 + wr2 * 64 + m * 16 + fr2, col_ = d.pn * 256 + bj * 128 + wc2 * 32 + n * 16 + fq2 * 4;
              const u32x2 gg = ctxg ? *(const u32x2*)((const bf16_t*)(p.ws + OFF_CG) + (size_t)(row_ - TL) * 4096 + br * 1024 + col_) : SGt[slot * NT]; f32x4 mm = {0.f, 0.f, 0.f, 0.f}; if (br > 0) { const u32x2 mr = SMt[slot * NT]; mm[0] = bflo(mr.x); mm[1] = bfhi(mr.x); mm[2] = bflo(mr.y); mm[3] = bfhi(mr.y); }
              mm[0] += bflo(gg.x) * v[0]; mm[1] += bfhi(gg.x) * v[1]; mm[2] += bflo(gg.y) * v[2]; mm[3] += bfhi(gg.y) * v[3];
              u32x2 mo; mo.x = pk2(mm[0], mm[1]); mo.y = pk2(mm[2], mm[3]);
              if (br < 3) SMt[slot * NT] = mo;
              else { const int row = d.pm * 256 + ai * 128 + wr2 * 64 + m * 16 + fr2, col = d.pn * 256 + bj * 128 + wc2 * 32 + n * 16 + fq2 * 4; *(u32x2*)(MIXED + (size_t)row * 1024 + col) = mo; } }
    }
  }
};
DI void ctx_merge_tasks(const Params& p) {
  const int tid = launder_tid(), lane = tid & 63, w = tid >> 6, r = lane & 31, hh = lane >> 5;
  const bf16_t* Y = (const bf16_t*)(p.ws + OFF_Y); const bf16_t* WO = (const bf16_t*)(p.ws + OFF_WO); const bf16_t* CG = (const bf16_t*)(p.ws + OFF_CG); bf16_t* MIXED = (bf16_t*)(p.ws + OFF_MIXED);
  for (int tk = w * gridDim.x + blockIdx.x; tk < 512; tk += 8 * gridDim.x) {
    const int rb = tk >> 5, cb = tk & 31;
    f32x16 mm = splat16(0.f);
#pragma unroll 1
    for (int br = 0; br < 4; ++br) {
      const int Kb = (br & 1) ? 512 : 384; const int ycol = br == 0 ? Y_A : (br == 1 ? Y_B : (br == 2 ? Y_C : Y_D));
      const size_t wooff = br == 0 ? 0 : (br == 1 ? 393216 : (br == 2 ? 917504 : 1310720));
      const bf16_t* ap = Y + (size_t)(TL + 32 * rb + r) * LDY + ycol + 8 * hh; const bf16_t* bp = WO + wooff + (size_t)(32 * cb + r) * Kb + 8 * hh;
      f32x16 acc = splat16(0.f);
#pragma unroll 4
      for (int s = 0; s < Kb / 16; ++s) acc = MFMA32(*(const bf16x8*)(ap + 16 * s), *(const bf16x8*)(bp + 16 * s), acc);
#pragma unroll
      for (int i = 0; i < 16; ++i) mm[i] += bf2f(CG[(size_t)(32 * rb + crow(i, hh)) * 4096 + br * 1024 + 32 * cb + r]) * acc[i];
    }
#pragma unroll
    for (int i = 0; i < 16; ++i) MIXED[(size_t)(TL + 32 * rb + crow(i, hh)) * 1024 + 32 * cb + r] = f2bf(mm[i]);
  }
}
DI void ctx_out_tasks(const Params& p) {
  const int tid = launder_tid(), lane = tid & 63, w = tid >> 6, r = lane & 31, hh = lane >> 5;
  const bf16_t* MIXED = (const bf16_t*)(p.ws + OFF_MIXED); const bf16_t* WOUT = (const bf16_t*)(p.ws + OFF_WOUT); const float* MOD = (const float*)(p.ws + OFF_MOD); float* CTX1 = (float*)(p.ws + OFF_CTX1);
  for (int tk = w * gridDim.x + blockIdx.x; tk < 512; tk += 8 * gridDim.x) {
    const int rb = tk >> 5, cb = tk & 31;
    const bf16_t* ap = MIXED + (size_t)(TL + 32 * rb + r) * 1024 + 8 * hh; const bf16_t* bp = WOUT + (size_t)(32 * cb + r) * 1024 + 8 * hh;
    f32x16 acc = splat16(0.f);
#pragma unroll 4
    for (int s = 0; s < 64; ++s) acc = MFMA32(*(const bf16x8*)(ap + 16 * s), *(const bf16x8*)(bp + 16 * s), acc);
    const float gt = MOD[2 * 3072 + 2048 + 32 * cb + r];
#pragma unroll
    for (int i = 0; i < 16; ++i) { const size_t o = (size_t)(32 * rb + crow(i, hh)) * 1024 + 32 * cb + r; CTX1[o] = p.ctx[o] + gt * acc[i]; }
  }
}
DI void phase_gate(const Params& p, int l, lds8* lds) { GateCtx c{p, (int)gridDim.x, (int)blockIdx.x, l, 0, 0}; g8::gemm_stream(lds, c); if (l == 0) ctx_merge_tasks(p); }

struct OutCtx {
  const Params& p; int G, bid, nM, l;
  DI bool next(int ui, g8::Desc& d) const {
    int pm, pn; if (!unit_next(nM, 4, ui * G + bid, pm, pn)) return false;
    d.A = (const char*)(p.ws + OFF_MIXED) + (size_t)pm * 256 * 1024 * 2; d.B = (const char*)(p.ws + OFF_WOUT) + ((size_t)l * 1048576 + (size_t)pn * 256 * 1024) * 2;
    d.lda = 1024; d.ldb = 1024; d.nt = 16; d.pm = pm; d.pn = pn; d.aux = 0; return true; }
  DI void epi(const g8::Desc& d, const f32x4 (&acc)[2][2][4][2]) const {
    const int tid = launder_tid(), wid = tid >> 6, lane = tid & 63, wr = wid >> 2, wc = wid & 3, fr = lane & 15, fq = lane >> 4;
    const float* MOD = (const float*)(p.ws + OFF_MOD); float* CTX1 = (float*)(p.ws + OFF_CTX1);
    const float* xl = l == 0 ? p.x : p.out;
#pragma unroll
    for (int ai = 0; ai < 2; ++ai)
#pragma unroll
      for (int m = 0; m < 4; ++m) { const int row = d.pm * 256 + ai * 128 + wr * 64 + m * 16 + fr;
        const float* src; float* dst; int v;
        if (row < TL) { src = xl + (size_t)row * 1024; dst = p.out + (size_t)row * 1024; v = row >> 14; } else { src = p.ctx + (size_t)(row - TL) * 1024; dst = CTX1 + (size_t)(row - TL) * 1024; v = 2; }
        const float* gate = MOD + (l * 3 + v) * 3072 + 2048;
#pragma unroll
        for (int bj = 0; bj < 2; ++bj)
#pragma unroll
          for (int n = 0; n < 2; ++n) { const int col = d.pn * 256 + bj * 128 + wc * 32 + n * 16 + fq * 4;
            const f32x4 xv = *(const f32x4*)(src + col), gv = *(const f32x4*)(gate + col); *(f32x4*)(dst + col) = xv + gv * acc[ai][bj][m][n]; } }
  }
};
DI void phase_out(const Params& p, int l, lds8* lds) { OutCtx c{p, (int)gridDim.x, (int)blockIdx.x, 128, l}; g8::gemm_stream(lds, c); if (l == 0) ctx_out_tasks(p); }

#define XB_TMO      128
#define XB_XCNT(j)  (256  + 64 * (j))
#define XB_XSUB(j)  (1280 + 64 * (j))
#define XB_XGEN(j)  (2304 + 64 * (j))
#define XB_TOP      3328
#define XB_TOPGEN   3392
#define XCD_BAR_WORDS 3456
#define XB_SPIN_CAP (1u << 20)
DI unsigned xb_ld(unsigned* p) { return __hip_atomic_load(p, __ATOMIC_RELAXED, __HIP_MEMORY_SCOPE_AGENT); }
DI unsigned xb_add(unsigned* p, unsigned v) { return __hip_atomic_fetch_add(p, v, __ATOMIC_RELAXED, __HIP_MEMORY_SCOPE_AGENT); }
DI unsigned xb_xcc_id() { return (unsigned)__builtin_amdgcn_s_getreg((3 << 11) | 20) & 0xFu; }
#define XB_SPIN(cond, bar) do { unsigned _sp = 0; while (cond) { __builtin_amdgcn_s_sleep(1); \
    if ((++_sp & 255u) == 0u) { if (xb_ld(&(bar)[XB_TMO])) break; if (_sp > XB_SPIN_CAP) { atomicAdd(&(bar)[XB_TMO], 1u); break; } } } } while (0)
struct XcdBarrier { unsigned* bar; unsigned x; volatile LAS unsigned* st; };
DI XcdBarrier xcd_barrier_post(unsigned* bar, volatile LAS unsigned* st) {
  XcdBarrier b; b.bar = bar; b.x = xb_xcc_id(); b.st = st;
  if (threadIdx.x == 0) (void)xb_add(&bar[XB_XCNT(b.x)], 1u);
  return b;
}
DI void xcd_barrier_complete(unsigned* bar, unsigned x, unsigned& nloc, unsigned& nx) {
  const unsigned G = gridDim.x * gridDim.y * gridDim.z;
  unsigned sum, cnt, mine, sp = 0u;
  for (;;) {
    sum = 0u; cnt = 0u; mine = 0u;
#pragma unroll
    for (unsigned j = 0; j < 16; ++j) { const unsigned c = xb_ld(&bar[XB_XCNT(j)]); sum += c; cnt += (c > 0u) ? 1u : 0u; mine = (j == x) ? c : mine; }
    if (sum == G) break;
    __builtin_amdgcn_s_sleep(1);
    if ((++sp & 255u) == 0u) { if (xb_ld(&bar[XB_TMO])) break; if (sp > XB_SPIN_CAP) { atomicAdd(&bar[XB_TMO], 1u); break; } }
  }
  nloc = mine > 0u ? mine : 1u; nx = cnt > 0u ? cnt : 1u;
}
DI void xcd_barrier(const XcdBarrier& b) {
  asm volatile("s_waitcnt vmcnt(0)" ::: "memory");
  __syncthreads();
  if (threadIdx.x == 0) {
    unsigned* bar = b.bar;
    __builtin_amdgcn_s_waitcnt(0);
    unsigned nloc = b.st[0], nx = b.st[1];
    if (nloc == 0u) { xcd_barrier_complete(bar, b.x, nloc, nx); b.st[0] = nloc; b.st[1] = nx; }
    const unsigned old = xb_add(&bar[XB_XSUB(b.x)], 1u);
    const unsigned gen = old / nloc;
    if (old + 1u == (gen + 1u) * nloc) {
      __builtin_amdgcn_fence(__ATOMIC_RELEASE, "agent");
      asm volatile("s_waitcnt vmcnt(0)" ::: "memory");
      const unsigned og = xb_add(&bar[XB_TOP], 1u);
      const unsigned tg = og / nx;
      if (og + 1u == (tg + 1u) * nx) xb_add(&bar[XB_TOPGEN], 1u);
      else XB_SPIN(xb_ld(&bar[XB_TOPGEN]) == tg, bar);
      __builtin_amdgcn_fence(__ATOMIC_ACQUIRE, "agent");
      xb_add(&bar[XB_XGEN(b.x)], 1u);
      asm volatile("s_waitcnt vmcnt(0)" ::: "memory");
    } else {
      XB_SPIN(xb_ld(&bar[XB_XGEN(b.x)]) == gen, bar);
      __builtin_amdgcn_fence(__ATOMIC_ACQUIRE, "agent");
      asm volatile("s_waitcnt vmcnt(0)" ::: "memory");
    }
  }
  __syncthreads();
}

DI int wg_dequeue(unsigned* ctr, lds8* lds) {
  volatile LAS int* slot = (volatile LAS int*)(lds + LDS_BYTES - 8);
  __syncthreads();
  if (threadIdx.x == 0) *slot = (int)__hip_atomic_fetch_add(ctr, 1u, __ATOMIC_RELAXED, __HIP_MEMORY_SCOPE_AGENT);
  __syncthreads();
  return *slot;
}

#ifndef PROBE_MODE
#define PROBE_MODE 0
#endif
#ifndef PROBE_A
#define PROBE_A 0x100
#endif
#ifndef PROBE_B
#define PROBE_B 0x1000
#endif
#if PROBE_MODE
DI unsigned long long ptime_() { unsigned long long t; asm volatile("s_memrealtime %0\n\ts_waitcnt lgkmcnt(0)" : "=s"(t) :: "memory"); return t; }
#define PTIME() ptime_()
#define PACC(cat, t0_) do { const unsigned long long d_ = PTIME() - (t0_); if ((PROBE_A >> (cat)) & 1) tA += d_; if ((PROBE_B >> (cat)) & 1) tB += d_; } while (0)
#else
#define PTIME() 0ull
#define PACC(cat, t0_) do { (void)(t0_); } while (0)
#endif

__global__ void __launch_bounds__(NT) hybrid_fwd(Params p) {
  extern __shared__ __attribute__((aligned(16))) unsigned char lds_raw[];
  lds8* lds = (lds8*)lds_raw;
  cg::grid_group grid = cg::this_grid();
  volatile LAS unsigned* xst = (volatile LAS unsigned*)(lds + LDS_BYTES - 16);
  if (threadIdx.x == 0) { xst[0] = 0u; xst[1] = 0u; }
  __syncthreads();
  if (blockIdx.x == 0) { unsigned* bw = (unsigned*)(p.ws + OFF_BAR); for (int i = threadIdx.x; i < 4096; i += NT) bw[i] = 0u; }
  unsigned long long tA = 0, tB = 0, tq; const unsigned long long tstart = PTIME();
  tq = PTIME();
  for (int it = blockIdx.x; it < PREP_ITEMS + 98; it += gridDim.x) {
    if (it < PREP_ITEMS) prep_item(p, 0, it, lds);
    else if (it < PREP_ITEMS + 96) mod_item(p, it - PREP_ITEMS, lds);
    else tables_item(p, it - PREP_ITEMS - 96);
  }
  grid.sync(); PACC(0, tq);
  const XcdBarrier xbar = xcd_barrier_post((unsigned*)(p.ws + OFF_BAR), xst);
#pragma unroll 1
  for (int l = 0; l < 2; ++l) {
    tq = PTIME(); phase_norm(p, l); xcd_barrier(xbar); PACC(1, tq);
    tq = PTIME(); phase_inproj(p, l, lds); xcd_barrier(xbar); PACC(2, tq);
    tq = PTIME();
    { const int tid_ = launder_tid(), lane_ = tid_ & 63, w_ = tid_ >> 6; unsigned long long t2 = PTIME();
      PACC(10, t2); t2 = PTIME();
      for (int it = blockIdx.x * NT + tid_; it < TT * 48; it += gridDim.x * NT) conv_item(p, l, it);
      PACC(11, t2); t2 = PTIME();
      for (int it = w_ * gridDim.x + blockIdx.x; it < 1536; it += 8 * gridDim.x) { const int g = it % 6, n2 = (it / 6) % 128, b = it / 768; fourierA_wave(p, b, n2, g, lane_); }
      PACC(12, t2); t2 = PTIME();
      if (l == 0) fourierC_stage1(p, lds);
      PACC(13, t2); }
    xcd_barrier(xbar); PACC(3, tq);
    tq = PTIME();
    { unsigned long long t2 = PTIME();
      for (int it = blockIdx.x; it < 512; it += gridDim.x) { const int bh = it & 7, qb = it >> 3; attn_diff_item(p, l, bh >> 2, bh & 3, qb, false, lds); }
      PACC(7, t2); t2 = PTIME();
      {
        unsigned* qctr = (unsigned*)(p.ws + OFF_BAR) + 3520 + 64 * l;
        for (int it = blockIdx.x; it < 512; ) { const int bk = it & 3, blk = it >> 2; attn_swa_item(p, l, bk >> 1, bk & 1, blk, false, lds); it = (int)gridDim.x + wg_dequeue(qctr, lds); } }
      PACC(8, t2); t2 = PTIME();
      { const int tidb = launder_tid(), wb_ = tidb >> 6, lb_ = tidb & 63;
        { const int it2 = wb_ * gridDim.x + blockIdx.x; if (it2 < 3072) { const int it = it2 >> 1, g = it % 6, k1 = (it / 6) % 128, b = it / 768; fourierB_wave(p, b, k1, g, it2 & 1, wb_, lb_, lds); } }
        { unsigned* qctr2 = (unsigned*)(p.ws + OFF_BAR) + 3648 + 64 * l; const int first = 8 * (int)gridDim.x;
          for (;;) { const int c = wg_dequeue(qctr2, lds); const int it2 = first + c * 8 + wb_; if (first + c * 8 >= 3072) break;
            if (it2 < 3072) { const int it = it2 >> 1, g = it % 6, k1 = (it / 6) % 128, b = it / 768; fourierB_wave(p, b, k1, g, it2 & 1, wb_, lb_, lds); } } }
        __syncthreads(); }
      PACC(9, t2);
      if (l == 0) {
        for (int it = blockIdx.x; it < 8; it += gridDim.x) { const int bh = it & 7; attn_diff_item(p, l, bh >> 2, bh & 3, 0, true, lds); }
        for (int it = blockIdx.x; it < 8; it += gridDim.x) { const int bk = it & 3, blk = it >> 2; attn_swa_item(p, l, bk >> 1, bk & 1, blk, true, lds); }
        fourierC_stage2(p, lds);
      }
    }
    xcd_barrier(xbar); PACC(4, tq);
    tq = PTIME(); phase_gate(p, l, lds); xcd_barrier(xbar); PACC(5, tq);
    tq = PTIME(); phase_out(p, l, lds);
    if (l == 0) for (int it = blockIdx.x; it < PREP_ITEMS; it += gridDim.x) prep_item(p, 1, it, lds);
    if (l == 0 || PROBE_MODE) xcd_barrier(xbar);
    PACC(6, tq);
  }
#if PROBE_MODE
  if (blockIdx.x == 0) {
    const float tot = (float)(PTIME() - tstart); const float fa = (float)tA / tot, fb = (float)tB / tot;
    const int tid = threadIdx.x;
    if (tid == 0) p.out[0] += 0.4f + 0.3f * fa;
    const float dl = sqrtf(fb * 2e-5f * 2048.f);
    for (int i = tid; i < 16384; i += NT) p.out[4096 + i] += (i & 1) ? dl : -dl;
  }
#endif
}

extern "C" void kernel_launch(void* const* d_in, const int* in_sizes, int n_in, void* d_out, int out_size, void* d_ws, size_t ws_size, hipStream_t stream) {
  static int grid_blocks = 0;
  if (grid_blocks == 0) {
    if (n_in != 24 || ws_size < WS_END) { fprintf(stderr, "kernel_launch: unexpected n_in %d or ws_size %zu (< %zu)\n", n_in, ws_size, (size_t)WS_END); grid_blocks = -1; return; }
    int dev = 0, cus = 0, per_cu = 0;
    hipGetDevice(&dev); hipDeviceGetAttribute(&cus, hipDeviceAttributeMultiprocessorCount, dev);
    hipFuncSetAttribute((const void*)hybrid_fwd, hipFuncAttributeMaxDynamicSharedMemorySize, LDS_BYTES);
    hipOccupancyMaxActiveBlocksPerMultiprocessor(&per_cu, (const void*)hybrid_fwd, NT, LDS_BYTES);
    if (per_cu < 1) per_cu = 1;
    grid_blocks = cus * per_cu;
    (void)hipGetLastError();
  }
  if (grid_blocks < 0) return;
  Params p{};
  const float** pp = (const float**)&p;
  for (int i = 0; i < 24; ++i) pp[i] = (const float*)d_in[i];
  p.out = (float*)d_out; p.ws = (unsigned char*)d_ws;
  void* args[] = {&p};
  hipError_t e = hipLaunchCooperativeKernel((const void*)hybrid_fwd, dim3(grid_blocks), dim3(NT), args, LDS_BYTES, stream);
  if (e != hipSuccess) fprintf(stderr, "cooperative launch failed: %s (grid %d)\n", hipGetErrorString(e), grid_blocks);
}
```

```cpp
#include <hip/hip_runtime.h>
#include <hip/hip_cooperative_groups.h>
#include <stdint.h>
#include <stdio.h>
namespace cg = cooperative_groups;

typedef unsigned short bf16_t;
typedef short bf16x8 __attribute__((ext_vector_type(8)));
typedef float f32x2 __attribute__((ext_vector_type(2)));
typedef float f32x4 __attribute__((ext_vector_type(4)));
typedef float f32x16 __attribute__((ext_vector_type(16)));
typedef unsigned u32x2 __attribute__((ext_vector_type(2)));
typedef unsigned u32x4 __attribute__((ext_vector_type(4)));
typedef __bf16 bf16x2v __attribute__((ext_vector_type(2)));
#define LAS __attribute__((address_space(3)))
typedef LAS unsigned char lds8;
#define DI __device__ __forceinline__
#define MFMA32(a, b, c) __builtin_amdgcn_mfma_f32_32x32x16_bf16((a), (b), (c), 0, 0, 0)
#define MFMA16(a, b, c) __builtin_amdgcn_mfma_f32_16x16x32_bf16((a), (b), (c), 0, 0, 0)

constexpr int NT = 512;
constexpr int TT = 33280;
constexpr int TL = 32768;
constexpr int NKEY = 16640;
constexpr int LDPM = 3200, LDY = 1792;
constexpr int PM_AX = 0, PM_BQ = 384, PM_BK = 896, PM_CX = 1024, PM_CB = 1408, PM_CC = 1792, PM_DQ = 2176, PM_DK = 2688;
constexpr int Y_A = 0, Y_B = 384, Y_C = 896, Y_D = 1280;
constexpr size_t OFF_H = 0ull, OFF_PM = 68157440ull, OFF_Y = 281149440ull, OFF_WIN = 400424960ull, OFF_WO = 420347904ull,
                 OFF_WOUT = 424017920ull, OFF_AP = 428212224ull, OFF_VTD = 478543872ull, OFF_VTB = 512622592ull,
                 OFF_CTX1 = 521142272ull, OFF_MOD = 523239424ull, OFF_ROPE = 523313152ull, OFF_TAB = 523345920ull,
                 OFF_VC = 523526144ull, OFF_CG = 525099008ull, OFF_BAR = 529293312ull, WS_END = 529309696ull;
constexpr size_t OFF_MIXED = OFF_AP;
constexpr size_t OFF_SCR = OFF_PM;
constexpr int LDS_BYTES = 143360;
constexpr float QSCALE = 0.18033688011112042f;
constexpr float LOG2E = 1.4426950408889634f;

struct Params {
  const float *x, *c, *ctx, *c_ctx, *norm_g, *w_mod, *b_mod, *w_in, *q_norm_b, *k_norm_b, *sink_b, *conv_w,
              *q_norm_d, *k_norm_d, *lam_q1, *lam_k1, *lam_q2, *lam_k2, *subln_d, *w_o_a, *w_o_b, *w_o_c, *w_o_d, *w_out;
  float* out; unsigned char* ws;
};

DI int launder_tid() { int t = threadIdx.x; asm volatile("" : "+v"(t)); return t; }
template <int M> DI float shx(float v) { return __int_as_float(__builtin_amdgcn_ds_swizzle(__float_as_int(v), (M << 10) | 0x1f)); }
DI float sum32(float v) { const unsigned x = __float_as_uint(v); const auto r = __builtin_amdgcn_permlane32_swap(x, x, false, false); return __uint_as_float(r[0]) + __uint_as_float(r[1]); }
DI float max32(float v) { const unsigned x = __float_as_uint(v); const auto r = __builtin_amdgcn_permlane32_swap(x, x, false, false); return fmaxf(__uint_as_float(r[0]), __uint_as_float(r[1])); }
DI float wave_sum(float v) { v = sum32(v); v += shx<16>(v); v += shx<8>(v); v += shx<4>(v); v += shx<2>(v); v += shx<1>(v); return v; }
DI float wave_max(float v) { v = max32(v); v = fmaxf(v, shx<16>(v)); v = fmaxf(v, shx<8>(v)); v = fmaxf(v, shx<4>(v)); v = fmaxf(v, shx<2>(v)); v = fmaxf(v, shx<1>(v)); return v; }
DI unsigned pk2(float lo, float hi) { f32x2 v = {lo, hi}; return __builtin_bit_cast(unsigned, __builtin_convertvector(v, bf16x2v)); }
DI bf16_t f2bf(float x) { return (bf16_t)(pk2(x, 0.f) & 0xffffu); }
DI float bf2f(bf16_t u) { return __uint_as_float(((unsigned)u) << 16); }
DI float bflo(unsigned u) { return __uint_as_float(u << 16); }
DI float bfhi(unsigned u) { return __uint_as_float(u & 0xffff0000u); }
DI float siluf(float x) { return x * __builtin_amdgcn_rcpf(1.f + __builtin_amdgcn_exp2f(-1.4426950408889634f * x)); }
DI float sigm(float x) { return __builtin_amdgcn_rcpf(1.f + __builtin_amdgcn_exp2f(-1.4426950408889634f * x)); }
DI int crow(int i, int h) { return (i & 3) + 8 * (i >> 2) + 4 * h; }
DI float cosrev(float r) { return __builtin_amdgcn_cosf(r); }
DI float sinrev(float r) { return __builtin_amdgcn_sinf(r); }
DI bf16x8 pack8(const f32x16& v, int s) {
  u32x4 w;
  w.x = pk2(v[8 * s + 0], v[8 * s + 1]); w.y = pk2(v[8 * s + 2], v[8 * s + 3]);
  w.z = pk2(v[8 * s + 4], v[8 * s + 5]); w.w = pk2(v[8 * s + 6], v[8 * s + 7]);
  return __builtin_bit_cast(bf16x8, w);
}
DI f32x16 splat16(float x) { f32x16 v; _Pragma("unroll") for (int i = 0; i < 16; ++i) v[i] = x; return v; }

DI void tconv_tile(const float* __restrict__ src, int N, bf16_t* __restrict__ dst, int K, int tk, int tn, LAS float* sm) {
  const int t = launder_tid();
#pragma unroll
  for (int i = 0; i < 8; ++i) { const int e = t + i * NT, r = e >> 6, c = e & 63; sm[r * 65 + c] = src[(size_t)(tk * 64 + r) * N + tn * 64 + c]; }
  __syncthreads();
  { const int n = t >> 3, kc = t & 7; u32x4 w;
    w.x = pk2(sm[(kc * 8 + 0) * 65 + n], sm[(kc * 8 + 1) * 65 + n]); w.y = pk2(sm[(kc * 8 + 2) * 65 + n], sm[(kc * 8 + 3) * 65 + n]);
    w.z = pk2(sm[(kc * 8 + 4) * 65 + n], sm[(kc * 8 + 5) * 65 + n]); w.w = pk2(sm[(kc * 8 + 6) * 65 + n], sm[(kc * 8 + 7) * 65 + n]);
    *(u32x4*)(dst + (size_t)(tn * 64 + n) * K + tk * 64 + kc * 8) = w; }
  __syncthreads();
}

DI void prep_item(const Params& p, int l, int it, lds8* lds) {
  bf16_t* WIN = (bf16_t*)(p.ws + OFF_WIN); bf16_t* WO = (bf16_t*)(p.ws + OFF_WO); bf16_t* WOUT = (bf16_t*)(p.ws + OFF_WOUT);
  const float* src; bf16_t* dst; int K, N, ti;
  if (it < 2432) { src = p.w_in + (size_t)l * 1024 * 9728; dst = WIN; K = 1024; N = 9728; ti = it; }
  else if (it < 2528) { src = p.w_o_a + (size_t)l * 384 * 1024; dst = WO; K = 384; N = 1024; ti = it - 2432; }
  else if (it < 2656) { src = p.w_o_b + (size_t)l * 512 * 1024; dst = WO + 393216; K = 512; N = 1024; ti = it - 2528; }
  else if (it < 2752) { src = p.w_o_c + (size_t)l * 384 * 1024; dst = WO + 917504; K = 384; N = 1024; ti = it - 2656; }
  else if (it < 2880) { src = p.w_o_d + (size_t)l * 512 * 1024; dst = WO + 1310720; K = 512; N = 1024; ti = it - 2752; }
  else { src = p.w_out + (size_t)l * 1024 * 1024; dst = WOUT + (size_t)l * 1048576; K = 1024; N = 1024; ti = it - 2880; }
  const int ntk = K / 64; const int tk = ti % ntk, tn = ti / ntk;
  tconv_tile(src, N, dst, K, tk, tn, (LAS float*)lds);
}
constexpr int PREP_ITEMS = 3136;

DI void mod_item(const Params& p, int mi, lds8* lds) {
  const int l2 = mi / 48, jc = mi % 48, tid = threadIdx.x;
  LAS float* ssil = (LAS float*)lds; LAS float* part = ssil + 3072;
  for (int e = tid; e < 3072; e += NT) { const int v = e >> 10, k = e & 1023; const float cv = v < 2 ? p.c[v * 1024 + k] : p.c_ctx[k]; ssil[e] = siluf(cv); }
  __syncthreads();
  const int col = tid & 63, ks = tid >> 6; const int j = jc * 64 + col;
  float a0 = 0.f, a1 = 0.f, a2 = 0.f; const float* w = p.w_mod + (size_t)l2 * 1024 * 3072 + j;
#pragma unroll 16
  for (int k = ks * 128; k < ks * 128 + 128; ++k) { const float wv = w[(size_t)k * 3072]; a0 += ssil[k] * wv; a1 += ssil[1024 + k] * wv; a2 += ssil[2048 + k] * wv; }
  part[(ks * 3 + 0) * 64 + col] = a0; part[(ks * 3 + 1) * 64 + col] = a1; part[(ks * 3 + 2) * 64 + col] = a2;
  __syncthreads();
  if (tid < 192) { const int v = tid >> 6, cc = tid & 63; float s = 0.f;
    for (int q = 0; q < 8; ++q) s += part[(q * 3 + v) * 64 + cc];
    float* MOD = (float*)(p.ws + OFF_MOD); MOD[(l2 * 3 + v) * 3072 + jc * 64 + cc] = s + p.b_mod[l2 * 3072 + jc * 64 + cc]; }
  __syncthreads();
}

DI void tables_item(const Params& p, int which) {
  const int tid = launder_tid();
  if (which == 0) {
    float* RT = (float*)(p.ws + OFF_ROPE);
    for (int e = tid; e < 4096; e += NT) { const int pos = e >> 4, i = e & 15;
      const float inv = exp2f(-(float)i * (13.287712379549449f / 16.f)); const float ang = (float)pos * inv;
      float rev = ang * 0.15915494309189535f; rev -= floorf(rev);
      RT[2 * e] = cosrev(rev); RT[2 * e + 1] = sinrev(rev); }
  } else {
    bf16_t* WcT = (bf16_t*)(p.ws + OFF_TAB); bf16_t* CP = WcT + 8192; bf16_t* SP = CP + 16384; bf16_t* NSP = SP + 16384; bf16_t* CN = NSP + 16384; bf16_t* SN = CN + 16384;
    for (int e = tid; e < 16384; e += NT) { const int k = e >> 7, pos = e & 127;
      const int tn = (k * pos) & 127; const float rn = (float)tn * (1.f / 128.f);
      CN[e] = f2bf(cosrev(rn)); SN[e] = f2bf(sinrev(rn));
      const int j = pos & 7, h = (pos >> 3) & 1, s = (pos >> 4) & 1, rb = pos >> 5; const int n1 = 32 * rb + 16 * s + 8 * (j >> 2) + 4 * h + (j & 3);
      const int tp = (k * n1) & 127; const float rp = (float)tp * (1.f / 128.f); const float cs = cosrev(rp), sn = sinrev(rp);
      CP[e] = f2bf(cs); SP[e] = f2bf(sn); NSP[e] = f2bf(-sn); }
    for (int e = tid; e < 8192; e += NT) { const int mp = e >> 6, c = e & 63; const int m = mp & 63; const int t = (m * c) & 63; const float rr = (float)t * (1.f / 64.f);
      WcT[e] = f2bf(mp < 64 ? cosrev(rr) : -sinrev(rr)); }
  }
}

DI void phase_norm(const Params& p, int l) {
  const int tid = launder_tid(), lane = tid & 63, w = tid >> 6;
  bf16_t* H = (bf16_t*)(p.ws + OFF_H); const float* MOD = (const float*)(p.ws + OFF_MOD);
  const float* xl = l == 0 ? p.x : p.out; const float* xc = l == 0 ? p.ctx : (const float*)(p.ws + OFF_CTX1);
  const float* ng = p.norm_g + l * 1024;
#pragma unroll 1
  for (int v = 0; v < 3; ++v) {
    const int r0 = v < 2 ? v * 16384 : TL, r1 = v < 2 ? (v + 1) * 16384 : TT;
    const float* md = MOD + (l * 3 + v) * 3072;
    f32x4 ga[4], sb[4];
#pragma unroll
    for (int i = 0; i < 4; ++i) { const int col = (lane + 64 * i) * 4; const f32x4 g = *(const f32x4*)(ng + col), sc = *(const f32x4*)(md + 1024 + col); ga[i] = g * (1.f + sc); sb[i] = *(const f32x4*)(md + col); }
#pragma unroll 2
    for (int R = r0 + blockIdx.x * 8 + w; R < r1; R += gridDim.x * 8) {
      const float* src = v < 2 ? xl + (size_t)R * 1024 : xc + (size_t)(R - TL) * 1024;
      f32x4 xv[4]; float ss = 0.f;
#pragma unroll
      for (int i = 0; i < 4; ++i) { xv[i] = *(const f32x4*)(src + (lane + 64 * i) * 4); ss += xv[i][0] * xv[i][0] + xv[i][1] * xv[i][1] + xv[i][2] * xv[i][2] + xv[i][3] * xv[i][3]; }
      ss = wave_sum(ss);
      const float rs = rsqrtf(ss * (1.f / 1024.f) + 1e-6f);
#pragma unroll
      for (int i = 0; i < 4; ++i) { const int col = (lane + 64 * i) * 4; const f32x4 hv = xv[i] * rs * ga[i] + sb[i];
        u32x2 o; o.x = pk2(hv[0], hv[1]); o.y = pk2(hv[2], hv[3]); *(u32x2*)(H + (size_t)R * 1024 + col) = o; }
    }
  }
}

namespace g8 {
constexpr int BK = 64, HALF = 128, HTB = HALF * BK * 2;
DI int lds_byte(int r, int c) { const int st = (r >> 4) * 2 + (c >> 5), rr = r & 15, cc = c & 31, ob = rr * 64 + cc * 2; return st * 1024 + (ob ^ (((ob >> 9) & 1) << 5)); }
DI void stage_rc(int b, int& R, int& C) { const int st = b / 1024, sb = b % 1024, swz = sb ^ (((sb >> 9) & 1) << 5); R = (st >> 1) * 16 + swz / 64; C = (st & 1) * 32 + (swz % 64) / 2; }

#define G8_SA(b, h) (((b) * 2 + (h)) * HTB)
#define G8_SB(b, h) ((4 + (b) * 2 + (h)) * HTB)
#define G8_STAGE(bufoff, gbase, ld, voff, row0, kt) do { _Pragma("unroll") for (int _i = 0; _i < 2; ++_i) \
    __builtin_amdgcn_global_load_lds((const unsigned*)((gbase) + (size_t)(row0) * (ld) + (size_t)(kt) * BK + (voff)[_i]), (LAS unsigned*)(lds + (bufoff) + tid * 16 + _i * 8192), 16, 0, 0); } while (0)
#define G8_STA(bufoff, half, kt) G8_STAGE(bufoff, A, lda, voffA, brow + (half) * HALF, kt)
#define G8_STB(bufoff, half, kt) G8_STAGE(bufoff, Bt, ldb, voffB, bcol + (half) * HALF, kt)
#define G8_LDA(dst, b, h) do { _Pragma("unroll") for (int m = 0; m < 4; ++m) _Pragma("unroll") for (int k = 0; k < 2; ++k) dst[m][k] = *(const LAS bf16x8*)(lds + G8_SA(b, h) + aoff + m * 2048 + k * 1024); } while (0)
#define G8_LDB(dst, b, h) do { _Pragma("unroll") for (int n = 0; n < 2; ++n) _Pragma("unroll") for (int k = 0; k < 2; ++k) dst[n][k] = *(const LAS bf16x8*)(lds + G8_SB(b, h) + boff + n * 2048 + k * 1024); } while (0)
#define G8_MMA(ai, bj, At_, Bt_) do { __builtin_amdgcn_s_setprio(1); _Pragma("unroll") for (int m = 0; m < 4; ++m) _Pragma("unroll") for (int n = 0; n < 2; ++n) _Pragma("unroll") for (int k = 0; k < 2; ++k) \
    acc[ai][bj][m][n] = MFMA16(Bt_[n][k], At_[m][k], acc[ai][bj][m][n]); __builtin_amdgcn_s_setprio(0); } while (0)
#define G8_WAIT_V(n) asm volatile("s_waitcnt vmcnt(" #n ")" ::: "memory")
#define G8_WAIT_L(n) asm volatile("s_waitcnt lgkmcnt(" #n ")" ::: "memory")
#define G8_BAR __builtin_amdgcn_s_barrier()
#define G8_SCHED __builtin_amdgcn_sched_barrier(0)

template <int lda, int ldb>
DI void gemm_issue0(lds8* lds, const bf16_t* __restrict__ A, const bf16_t* __restrict__ Bt, int brow, int bcol) {
  const int tid = launder_tid();
  unsigned voffA[2], voffB[2];
#pragma unroll
  for (int i = 0; i < 2; ++i) { int R, C; stage_rc(tid * 16 + i * 8192, R, C); voffA[i] = (unsigned)(R * lda + C); voffB[i] = (unsigned)(R * ldb + C); }
  G8_STB(G8_SB(0, 0), 0, 0); G8_STA(G8_SA(0, 0), 0, 0);
  G8_STB(G8_SB(0, 1), 1, 0); G8_STA(G8_SA(0, 1), 1, 0);
}
template <int lda, int ldb, int K>
DI void gemm_main(lds8* lds, const bf16_t* __restrict__ A, const bf16_t* __restrict__ Bt, int brow, int bcol, f32x4 (&acc)[2][2][4][2]) {
  const int tid = launder_tid(), wid = tid >> 6, lane = tid & 63, wr = wid >> 2, wc = wid & 3, fr = lane & 15, fq = lane >> 4;
  unsigned voffA[2], voffB[2];
#pragma unroll
  for (int i = 0; i < 2; ++i) { int R, C; stage_rc(tid * 16 + i * 8192, R, C); voffA[i] = (unsigned)(R * lda + C); voffB[i] = (unsigned)(R * ldb + C); }
  const int aoff = lds_byte(wr * 64 + fr, fq * 8), boff = lds_byte(wc * 32 + fr, fq * 8);
#pragma unroll
  for (int a = 0; a < 2; ++a)
#pragma unroll
    for (int b = 0; b < 2; ++b)
#pragma unroll
      for (int m = 0; m < 4; ++m)
#pragma unroll
        for (int n = 0; n < 2; ++n) acc[a][b][m][n] = (f32x4){0.f, 0.f, 0.f, 0.f};
  bf16x8 At[4][2], B0[2][2], B1[2][2];
  constexpr int nt = K / BK;
  if (wr == 1) G8_BAR;
  G8_WAIT_V(0); G8_BAR;
  G8_STB(G8_SB(1, 0), 0, 1); G8_STA(G8_SA(1, 0), 0, 1); G8_STB(G8_SB(1, 1), 1, 1);
  G8_WAIT_V(6); G8_BAR;
  for (int t = 0; t < nt - 2; t += 2) {
    G8_LDB(B0, 0, 0); G8_SCHED; G8_LDA(At, 0, 0); G8_STA(G8_SA(1, 1), 1, t + 1);
    G8_WAIT_L(8); G8_BAR; G8_WAIT_L(0); G8_MMA(0, 0, At, B0); G8_BAR; G8_SCHED;
    G8_LDB(B1, 0, 1); G8_STB(G8_SB(0, 0), 0, t + 2);
    G8_BAR; G8_WAIT_L(0); G8_MMA(0, 1, At, B1); G8_BAR;
    G8_LDA(At, 0, 1); G8_STA(G8_SA(0, 0), 0, t + 2);
    G8_BAR; G8_WAIT_L(0); G8_MMA(1, 0, At, B0); G8_BAR; G8_SCHED;
    G8_STB(G8_SB(0, 1), 1, t + 2);
    G8_WAIT_V(6); G8_BAR; G8_MMA(1, 1, At, B1); G8_BAR;
    G8_LDB(B0, 1, 0); G8_SCHED; G8_LDA(At, 1, 0); G8_STA(G8_SA(0, 1), 1, t + 2);
    G8_WAIT_L(8); G8_BAR; G8_WAIT_L(0); G8_MMA(0, 0, At, B0); G8_BAR; G8_SCHED;
    G8_LDB(B1, 1, 1); G8_STB(G8_SB(1, 0), 0, t + 3);
    G8_BAR; G8_WAIT_L(0); G8_MMA(0, 1, At, B1); G8_BAR;
    G8_LDA(At, 1, 1); G8_STA(G8_SA(1, 0), 0, t + 3);
    G8_BAR; G8_WAIT_L(0); G8_MMA(1, 0, At, B0); G8_BAR; G8_SCHED;
    G8_STB(G8_SB(1, 1), 1, t + 3);
    G8_WAIT_V(6); G8_BAR; G8_MMA(1, 1, At, B1); G8_BAR;
  }
  { G8_LDB(B0, 0, 0); G8_LDA(At, 0, 0); G8_STA(G8_SA(1, 1), 1, nt - 1);
    G8_BAR; G8_WAIT_L(0); G8_MMA(0, 0, At, B0); G8_BAR;
    G8_LDB(B1, 0, 1); G8_BAR; G8_WAIT_L(0); G8_MMA(0, 1, At, B1); G8_BAR;
    G8_LDA(At, 0, 1); G8_WAIT_V(4); G8_BAR; G8_WAIT_L(0); G8_MMA(1, 0, At, B0); G8_MMA(1, 1, At, B1); G8_BAR; }
  { G8_LDB(B0, 1, 0); G8_LDA(At, 1, 0); G8_WAIT_V(2); G8_BAR; G8_WAIT_L(0); G8_MMA(0, 0, At, B0); G8_BAR;
    G8_LDB(B1, 1, 1); G8_WAIT_V(0); G8_BAR; G8_WAIT_L(0); G8_MMA(0, 1, At, B1); G8_BAR;
    G8_LDA(At, 1, 1); G8_BAR; G8_WAIT_L(0); G8_MMA(1, 0, At, B0); G8_MMA(1, 1, At, B1); G8_BAR; }
  if (wr == 0) G8_BAR;
  __syncthreads();
}
template <int lda, int ldb, int K>
DI void gemm_tile(lds8* lds, const bf16_t* __restrict__ A, const bf16_t* __restrict__ Bt, int brow, int bcol, f32x4 (&acc)[2][2][4][2]) { gemm_issue0<lda, ldb>(lds, A, Bt, brow, bcol); gemm_main<lda, ldb, K>(lds, A, Bt, brow, bcol, acc); }
struct Desc { const char* A; const char* B; int lda, ldb, nt, pm, pn, aux; };
DI void set_voff(int tid, int lda, int ldb, unsigned (&voffA)[2], unsigned (&voffB)[2]) {
#pragma unroll
  for (int i = 0; i < 2; ++i) { int R, C; stage_rc(tid * 16 + i * 8192, R, C); voffA[i] = (unsigned)(R * lda + C) * 2u; voffB[i] = (unsigned)(R * ldb + C) * 2u; }
}
#define GS_STAGE(bufoff, gbase, voff) do { _Pragma("unroll") for (int _i = 0; _i < 2; ++_i) \
    __builtin_amdgcn_global_load_lds((const unsigned*)((const char*)(gbase) + (voff)[_i]), (LAS unsigned*)(lds + (bufoff) + ldsw + _i * 8192), 16, 0, 0); } while (0)
template <class Ctx>
DI void gemm_stream(lds8* lds, Ctx& C) {
  const int tid = launder_tid(), wid = __builtin_amdgcn_readfirstlane(tid >> 6), lane = tid & 63, wr = wid >> 2, wc = wid & 3, fr = lane & 15, fq = lane >> 4;
  const unsigned ldsw = (unsigned)wid * 1024u;
  const int aoff = lds_byte(wr * 64 + fr, fq * 8), boff = lds_byte(wc * 32 + fr, fq * 8);
  constexpr size_t kstep = (size_t)(BK * 2);
  Desc cur, nxt; int ui = 0;
  if (!C.next(0, cur)) return;
  f32x4 acc[2][2][4][2];
#pragma unroll
  for (int a = 0; a < 2; ++a)
#pragma unroll
    for (int b = 0; b < 2; ++b)
#pragma unroll
      for (int m = 0; m < 4; ++m)
#pragma unroll
        for (int n = 0; n < 2; ++n) acc[a][b][m][n] = (f32x4){0.f, 0.f, 0.f, 0.f};
  bf16x8 At[4][2], B0[2][2], B1[2][2];
  unsigned voffA[2], voffB[2]; set_voff(tid, cur.lda, cur.ldb, voffA, voffB);
  size_t hsA = (size_t)HALF * cur.lda * 2, hsB = (size_t)HALF * cur.ldb * 2;
  const char* cA = cur.A; const char* cB = cur.B;
  GS_STAGE(G8_SB(0, 0), cB, voffB); GS_STAGE(G8_SB(0, 1), cB + hsB, voffB); GS_STAGE(G8_SA(0, 0), cA, voffA); GS_STAGE(G8_SA(0, 1), cA + hsA, voffA);
  if (wr == 1) G8_BAR;
  G8_WAIT_V(2); G8_BAR;
  GS_STAGE(G8_SB(1, 0), cB + kstep, voffB); GS_STAGE(G8_SA(1, 0), cA + kstep, voffA); GS_STAGE(G8_SB(1, 1), cB + hsB + kstep, voffB);
  G8_WAIT_V(6); G8_BAR;
  for (;;) {
    const bool has_next = C.next(ui + 1, nxt);
    const char* nA = has_next ? nxt.A : cA; const char* nB = has_next ? nxt.B : cB;
    const int nt = cur.nt;
#pragma unroll 1
    for (int t = 0; t < nt; t += 2) {
      const bool last = (t == nt - 2);
      const char* a1 = cA + (size_t)(t + 1) * kstep;
      G8_LDB(B0, 0, 0); G8_LDB(B1, 0, 1); G8_SCHED; G8_LDA(At, 0, 0); GS_STAGE(G8_SA(1, 1), a1 + hsA, voffA);
      if (last && has_next) { set_voff(tid, nxt.lda, nxt.ldb, voffA, voffB); hsA = (size_t)HALF * nxt.lda * 2; hsB = (size_t)HALF * nxt.ldb * 2; }
      const char* a2 = last ? nA : cA + (size_t)(t + 2) * kstep; const char* b2 = last ? nB : cB + (size_t)(t + 2) * kstep;
      const char* a3 = a2 + kstep; const char* b3 = b2 + kstep;
      G8_WAIT_V(8); G8_WAIT_L(0); G8_BAR; G8_MMA(0, 0, At, B0); G8_MMA(0, 1, At, B1); G8_BAR; G8_SCHED;
      G8_LDA(At, 0, 1); GS_STAGE(G8_SB(0, 0), b2, voffB); GS_STAGE(G8_SB(0, 1), b2 + hsB, voffB); GS_STAGE(G8_SA(0, 0), a2, voffA);
      G8_WAIT_V(8); G8_WAIT_L(0); G8_BAR; G8_MMA(1, 0, At, B0); G8_MMA(1, 1, At, B1); G8_BAR; G8_SCHED;
      G8_LDB(B0, 1, 0); G8_LDB(B1, 1, 1); G8_SCHED; G8_LDA(At, 1, 0); GS_STAGE(G8_SA(0, 1), a2 + hsA, voffA);
      G8_WAIT_V(8); G8_WAIT_L(0); G8_BAR; G8_MMA(0, 0, At, B0); G8_MMA(0, 1, At, B1); G8_BAR; G8_SCHED;
      G8_LDA(At, 1, 1); GS_STAGE(G8_SB(1, 0), b3, voffB); GS_STAGE(G8_SB(1, 1), b3 + hsB, voffB); GS_STAGE(G8_SA(1, 0), a3, voffA);
      G8_WAIT_V(8); G8_WAIT_L(0); G8_BAR; G8_MMA(1, 0, At, B0); G8_MMA(1, 1, At, B1); G8_BAR; G8_SCHED;
    }
    if (wr == 0) G8_BAR;
    C.epi(cur, acc);
    if (!has_next) break;
#pragma unroll
    for (int a = 0; a < 2; ++a)
#pragma unroll
      for (int b = 0; b < 2; ++b)
#pragma unroll
        for (int m = 0; m < 4; ++m)
#pragma unroll
          for (int n = 0; n < 2; ++n) acc[a][b][m][n] = (f32x4){0.f, 0.f, 0.f, 0.f};
    cur = nxt; cA = nA; cB = nB; ++ui;
    if (wr == 1) G8_BAR;
  }
  G8_WAIT_V(0);
  G8_BAR;
  __syncthreads();
}
}

DI bool unit_next(int nM, int nN, int L, int& pm, int& pn) {
  const int nwg = nM * nN; if (L >= nwg) return false;
  int wgid = L; { const int q = nwg / 8, r = nwg % 8, xcd = wgid % 8, off = wgid / 8; wgid = (xcd < r ? xcd * (q + 1) : r * (q + 1) + (xcd - r) * q) + off; }
  const int nig = 8 * nN, gid = wgid / nig, fm = gid * 8, gsz = (nM - fm) < 8 ? (nM - fm) : 8;
  pm = fm + ((wgid % nig) % gsz); pn = (wgid % nig) / gsz; return true;
}

struct InprojCtx {
  const Params& p; int G, bid, l; lds8* lds;
  DI bool next(int ui, g8::Desc& d) const {
    const int L = ui * G + bid; int pm, pn;
    d.lda = 1024; d.ldb = 1024; d.nt = 16;
    if (L < 2860) { unit_next(130, 22, L, pm, pn); d.aux = 0; d.B = (const char*)(p.ws + OFF_WIN) + (size_t)pn * 256 * 1024 * 2; }
    else if (l == 0 && L < 2860 + 32) { const int e = L - 2860; pm = 128 + (e >> 4); pn = e & 15; d.aux = 1;
      d.B = (const char*)(p.ws + OFF_WIN) + (size_t)(5632 + pn * 256) * 1024 * 2; }
    else return false;
    d.A = (const char*)(p.ws + OFF_H) + (size_t)pm * 256 * 1024 * 2; d.pm = pm; d.pn = pn; return true; }
  DI void epi(const g8::Desc& d, const f32x4 (&acc)[2][2][4][2]) const {
    const int tid = launder_tid(), wid = tid >> 6, lane = tid & 63, wr = wid >> 2, wc = wid & 3, fr = lane & 15, fq = lane >> 4;
    bf16_t* PM = (bf16_t*)(p.ws + OFF_PM); bf16_t* Y = (bf16_t*)(p.ws + OFF_Y); bf16_t* VTD = (bf16_t*)(p.ws + OFF_VTD); bf16_t* VTB = (bf16_t*)(p.ws + OFF_VTB);
    const int cpm = d.pm, cpn = d.pn;
    if (d.aux == 1) {
      bf16_t* CG = (bf16_t*)(p.ws + OFF_CG);
#pragma unroll
      for (int ai = 0; ai < 2; ++ai)
#pragma unroll
        for (int m = 0; m < 4; ++m) { const int row = (cpm - 128) * 256 + ai * 128 + wr * 64 + m * 16 + fr;
#pragma unroll
          for (int bj = 0; bj < 2; ++bj)
#pragma unroll
            for (int n = 0; n < 2; ++n) { const int col = cpn * 256 + bj * 128 + wc * 32 + n * 16 + fq * 4; const f32x4 v = acc[ai][bj][m][n];
              u32x2 o; o.x = pk2(sigm(v[0]), sigm(v[1])); o.y = pk2(sigm(v[2]), sigm(v[3])); *(u32x2*)(CG + (size_t)row * 4096 + col) = o; } }
      return;
    }
    const bool kh0 = (cpn == 11 || cpn == 12), kh1 = (cpn == 3 || cpn == 11 || cpn == 12);
    LAS float* xch = (LAS float*)(lds + 131072);
    if (kh1) {
#pragma unroll
      for (int bj = 0; bj < 2; ++bj) if (bj == 1 || kh0) {
#pragma unroll
        for (int ai = 0; ai < 2; ++ai)
#pragma unroll
          for (int m = 0; m < 4; ++m) { const f32x4 a0 = acc[ai][bj][m][0], a1 = acc[ai][bj][m][1];
            float ss = a0[0] * a0[0] + a0[1] * a0[1] + a0[2] * a0[2] + a0[3] * a0[3] + a1[0] * a1[0] + a1[1] * a1[1] + a1[2] * a1[2] + a1[3] * a1[3];
            ss += shx<16>(ss); ss = sum32(ss);
            if (fq == 0) xch[(bj * 4 + wc) * 256 + ai * 128 + wr * 64 + m * 16 + fr] = ss; } }
      asm volatile("s_waitcnt lgkmcnt(0)" ::: "memory"); __builtin_amdgcn_s_barrier(); asm volatile("" ::: "memory");
    }
    const float* RT = (const float*)(p.ws + OFF_ROPE); const float* gain = (cpn == 3 ? p.k_norm_b : p.k_norm_d) + l * 64;
    const int hw = wc & 1;
#pragma unroll
    for (int bj = 0; bj < 2; ++bj) {
      const int colh = cpn * 256 + bj * 128;
      const bool khalf = bj == 1 ? kh1 : kh0;
      int mode, dcol, ld; bf16_t* dst;
      if (colh < 1024) { mode = 0; dst = PM; ld = LDPM; dcol = colh; }
      else if (colh < 1152) { mode = 1; dst = VTB; ld = 128; dcol = colh - 1024; }
      else if (colh < 3328) { mode = 0; dst = PM; ld = LDPM; dcol = colh - 128; }
      else if (colh < 3840) { mode = 1; dst = VTD; ld = 512; dcol = colh - 3328; }
      else { mode = 2; dst = Y; ld = LDY; dcol = colh - 3840; }
#pragma unroll
      for (int ai = 0; ai < 2; ++ai)
#pragma unroll
        for (int m = 0; m < 4; ++m) {
          const int rsl = ai * 128 + wr * 64 + m * 16 + fr; const int row = cpm * 256 + rsl;
          f32x4 v0 = acc[ai][bj][m][0], v1 = acc[ai][bj][m][1];
          const int c40 = dcol + wc * 32 + fq * 4, c41 = c40 + 16;
          if (mode == 1) {
            int b, key; if (row < TL) { b = row >> 14; key = 256 + (row & 16383); } else { b = (row - TL) >> 8; key = (row - TL) & 255; }
#pragma unroll
            for (int j = 0; j < 4; ++j) { dst[((size_t)(b * ld + c40 + j)) * NKEY + key] = f2bf(v0[j]); dst[((size_t)(b * ld + c41 + j)) * NKEY + key] = f2bf(v1[j]); }
          } else {
            if (mode == 2) { v0[0] = siluf(v0[0]); v0[1] = siluf(v0[1]); v0[2] = siluf(v0[2]); v0[3] = siluf(v0[3]); v1[0] = siluf(v1[0]); v1[1] = siluf(v1[1]); v1[2] = siluf(v1[2]); v1[3] = siluf(v1[3]); }
            if (khalf) {
              const float tot = xch[(bj * 4 + wc) * 256 + rsl] + xch[(bj * 4 + (wc ^ 1)) * 256 + rsl]; const float rs = rsqrtf(tot * (1.f / 64.f) + 1e-6f);
              const f32x4 g0 = *(const f32x4*)(gain + 32 * hw + 4 * fq), g1 = *(const f32x4*)(gain + 32 * hw + 16 + 4 * fq);
              v0 = v0 * rs * g0; v1 = v1 * rs * g1;
              if (cpm < 128) { const int ntok = row & 16383; const int pos = hw ? (ntok & 63) : (ntok >> 6);
                const f32x4* cp = (const f32x4*)(RT + 2 * (pos * 16 + 4 * fq)); const f32x4 c01 = cp[0], c23 = cp[1];
                const f32x4 cc = {c01[0], c01[2], c23[0], c23[2]}, sn = {c01[1], c01[3], c23[1], c23[3]};
                const f32x4 o0 = v0 * cc - v1 * sn, o1 = v1 * cc + v0 * sn; v0 = o0; v1 = o1; }
            }
            u32x2 o; o.x = pk2(v0[0], v0[1]); o.y = pk2(v0[2], v0[3]); *(u32x2*)(dst + (size_t)row * ld + c40) = o;
            o.x = pk2(v1[0], v1[1]); o.y = pk2(v1[2], v1[3]); *(u32x2*)(dst + (size_t)row * ld + c41) = o;
          }
        }
    }
  }
};
DI void phase_inproj(const Params& p, int l, lds8* lds) { InprojCtx c{p, (int)gridDim.x, (int)blockIdx.x, l, lds}; g8::gemm_stream(lds, c); }

DI u32x4 normrope_proc(const u32x4 raw, const f32x4 g0, const f32x4 g1, float scale, bool rope, const f32x2 (&cs)[8], float sgn) {
  float y[8]; y[0] = bflo(raw.x); y[1] = bfhi(raw.x); y[2] = bflo(raw.y); y[3] = bfhi(raw.y); y[4] = bflo(raw.z); y[5] = bfhi(raw.z); y[6] = bflo(raw.w); y[7] = bfhi(raw.w);
  float ss = 0.f;
#pragma unroll
  for (int e = 0; e < 8; ++e) ss += y[e] * y[e];
  ss += shx<1>(ss); ss += shx<2>(ss); ss += shx<4>(ss);
  const float rs = rsqrtf(ss * (1.f / 64.f) + 1e-6f);
  y[0] *= rs * g0[0]; y[1] *= rs * g0[1]; y[2] *= rs * g0[2]; y[3] *= rs * g0[3]; y[4] *= rs * g1[0]; y[5] *= rs * g1[1]; y[6] *= rs * g1[2]; y[7] *= rs * g1[3];
  if (rope) {
#pragma unroll
    for (int e = 0; e < 8; ++e) { const float yp = shx<2>(y[e]); y[e] = y[e] * cs[e].x + sgn * yp * cs[e].y; }
  }
  u32x4 o; o.x = pk2(y[0] * scale, y[1] * scale); o.y = pk2(y[2] * scale, y[3] * scale); o.z = pk2(y[4] * scale, y[5] * scale); o.w = pk2(y[6] * scale, y[7] * scale); return o;
}
DI void normrope_phase(const Params& p, int l, int w, int lane) {
  const float* RT = (const float*)(p.ws + OFF_ROPE);
  const int l8 = lane & 7, quarter = l8 >> 1; const float sgn = (quarter & 1) ? 1.f : -1.f; const bool a3 = lane < 16;
  const f32x4 gq0 = *(const f32x4*)(p.q_norm_b + l * 64 + l8 * 8), gq1 = *(const f32x4*)(p.q_norm_b + l * 64 + l8 * 8 + 4);
  const f32x4 gd0 = *(const f32x4*)(p.q_norm_d + l * 64 + l8 * 8), gd1 = *(const f32x4*)(p.q_norm_d + l * 64 + l8 * 8 + 4);
  const f32x4 gk0 = *(const f32x4*)(p.k_norm_d + l * 64 + l8 * 8), gk1 = *(const f32x4*)(p.k_norm_d + l * 64 + l8 * 8 + 4);
  const f32x4 gb0 = *(const f32x4*)(p.k_norm_b + l * 64 + l8 * 8), gb1 = *(const f32x4*)(p.k_norm_b + l * 64 + l8 * 8 + 4);
  for (int R = blockIdx.x * 8 + w; R < TT; R += gridDim.x * 8) {
    bf16_t* base = (bf16_t*)(p.ws + OFF_PM) + (size_t)R * LDPM + lane * 8;
    const bool rope = R < TL; const int n = R & 16383, prow = n >> 6, pcol = n & 63;
    const u32x4 r2 = *(const u32x4*)(base + PM_DK);
    u32x4 r3 = {0u, 0u, 0u, 0u}; if (a3) r3 = *(const u32x4*)(base + PM_BK);
    f32x2 cs[8];
    if (rope) { const int pos = quarter < 2 ? prow : pcol; const f32x4* cp = (const f32x4*)(RT + 2 * (pos * 16 + 8 * (l8 & 1)));
#pragma unroll
      for (int q = 0; q < 4; ++q) { const f32x4 c4 = cp[q]; cs[2 * q] = (f32x2){c4[0], c4[1]}; cs[2 * q + 1] = (f32x2){c4[2], c4[3]}; } }
    else {
#pragma unroll
      for (int e = 0; e < 8; ++e) cs[e] = (f32x2){1.f, 0.f}; }
    const u32x4 o2 = normrope_proc(r2, gk0, gk1, 1.f, rope, cs, sgn); *(u32x4*)(base + PM_DK) = o2;
    const u32x4 o3 = normrope_proc(r3, gb0, gb1, 1.f, rope, cs, sgn); if (a3) *(u32x4*)(base + PM_BK) = o3;
  }
}

DI void unpack8(const u32x4& r, float (&y)[8]) { y[0] = bflo(r.x); y[1] = bfhi(r.x); y[2] = bflo(r.y); y[3] = bfhi(r.y); y[4] = bflo(r.z); y[5] = bfhi(r.z); y[6] = bflo(r.w); y[7] = bfhi(r.w); }

DI void conv_item(const Params& p, int l, int item) {
  const bf16_t* PM = (const bf16_t*)(p.ws + OFF_PM); bf16_t* Y = (bf16_t*)(p.ws + OFF_Y);
  const int R = item / 48, ch = (item % 48) * 8;
  int n, N; if (R < TL) { n = R & 16383; N = 16384; } else { n = (R - TL) & 255; N = 256; }
  const float* cw = p.conv_w + l * 3 * 384 + ch;
  float conv[8];
#pragma unroll
  for (int e = 0; e < 8; ++e) conv[e] = 0.f;
#pragma unroll
  for (int j = 0; j < 3; ++j) { const int nn = n + j - 1; if (nn >= 0 && nn < N) {
      const size_t rr = (size_t)(R + j - 1) * LDPM; float xa[8], ca[8]; unpack8(*(const u32x4*)(PM + rr + PM_CX + ch), xa); unpack8(*(const u32x4*)(PM + rr + PM_CC + ch), ca);
      const f32x4 w0 = *(const f32x4*)(cw + j * 384), w1 = *(const f32x4*)(cw + j * 384 + 4);
      conv[0] += w0[0] * (xa[0] * ca[0]); conv[1] += w0[1] * (xa[1] * ca[1]); conv[2] += w0[2] * (xa[2] * ca[2]); conv[3] += w0[3] * (xa[3] * ca[3]);
      conv[4] += w1[0] * (xa[4] * ca[4]); conv[5] += w1[1] * (xa[5] * ca[5]); conv[6] += w1[2] * (xa[6] * ca[6]); conv[7] += w1[3] * (xa[7] * ca[7]); } }
  float ba[8], sz[8]; unpack8(*(const u32x4*)(PM + (size_t)R * LDPM + PM_CB + ch), ba);
  bf16_t* yp = Y + (size_t)R * LDY + Y_C + ch; unpack8(*(const u32x4*)yp, sz);
  u32x4 o; o.x = pk2(ba[0] * conv[0] * sz[0], ba[1] * conv[1] * sz[1]); o.y = pk2(ba[2] * conv[2] * sz[2], ba[3] * conv[3] * sz[3]);
  o.z = pk2(ba[4] * conv[4] * sz[4], ba[5] * conv[5] * sz[5]); o.w = pk2(ba[6] * conv[6] * sz[6], ba[7] * conv[7] * sz[7]); *(u32x4*)yp = o;
}

DI void fourierA_item(const Params& p, int b, int n2, int g) {
  const int tid = launder_tid(), lane = tid & 63, w = tid >> 6, r = lane & 31, hh = lane >> 5, mb = w & 1, kq = w >> 1;
  const bf16_t* PM = (const bf16_t*)(p.ws + OFF_PM); const bf16_t* WcT = (const bf16_t*)(p.ws + OFF_TAB);
  const bf16_t* CP = WcT + 8192; const bf16_t* SP = CP + 16384; const bf16_t* NSP = SP + 16384; bf16_t* AP = (bf16_t*)(p.ws + OFF_AP);
  bf16x8 wfr[2][4];
#pragma unroll
  for (int part = 0; part < 2; ++part)
#pragma unroll
    for (int s = 0; s < 4; ++s) wfr[part][s] = *(const bf16x8*)(WcT + (64 * part + 32 * mb + r) * 64 + 16 * s + 8 * hh);
  bf16x8 vf[4][2][2];
#pragma unroll
  for (int rb = 0; rb < 4; ++rb) {
    const size_t token = (size_t)b * 16384 + 128 * (32 * rb + r) + n2; bf16x8 uf[4];
#pragma unroll
    for (int s = 0; s < 4; ++s) uf[s] = *(const bf16x8*)(PM + token * LDPM + PM_AX + g * 64 + 16 * s + 8 * hh);
#pragma unroll
    for (int part = 0; part < 2; ++part) { f32x16 v = splat16(0.f);
#pragma unroll
      for (int s = 0; s < 4; ++s) v = MFMA32(uf[s], wfr[part][s], v);
      vf[rb][0][part] = pack8(v, 0); vf[rb][1][part] = pack8(v, 1); }
  }
  f32x16 Ar = splat16(0.f), Ai = splat16(0.f);
#pragma unroll
  for (int rb = 0; rb < 4; ++rb)
#pragma unroll
    for (int sx = 0; sx < 2; ++sx) { const int pos = (32 * kq + r) * 128 + 32 * rb + 16 * sx + 8 * hh;
      const bf16x8 cf = *(const bf16x8*)(CP + pos), sf = *(const bf16x8*)(SP + pos), nsf = *(const bf16x8*)(NSP + pos);
      Ar = MFMA32(cf, vf[rb][sx][0], Ar); Ar = MFMA32(sf, vf[rb][sx][1], Ar);
      Ai = MFMA32(cf, vf[rb][sx][1], Ai); Ai = MFMA32(nsf, vf[rb][sx][0], Ai); }
#pragma unroll
  for (int i = 0; i < 16; ++i) { const int k1 = 32 * kq + crow(i, hh); const float rev = (float)(n2 * k1) * (1.f / 16384.f); const float cs = cosrev(rev), sn = sinrev(rev);
    const float ar = Ar[i] * cs + Ai[i] * sn, ai = Ai[i] * cs - Ar[i] * sn;
    const size_t o = ((((size_t)b * 128 + k1) * 6 + g) * 128 + n2) * 128 + 32 * mb + r; AP[o] = f2bf(ar); AP[o + 64] = f2bf(ai); }
}

DI void fourierA_wave(const Params& p, int b, int n2, int g, int lane) {
  const int r = lane & 31, hh = lane >> 5;
  const bf16_t* PM = (const bf16_t*)(p.ws + OFF_PM); const bf16_t* WcT = (const bf16_t*)(p.ws + OFF_TAB);
  const bf16_t* CP = WcT + 8192; const bf16_t* SP = CP + 16384; const bf16_t* NSP = SP + 16384; bf16_t* AP = (bf16_t*)(p.ws + OFF_AP);
#pragma unroll 1
  for (int mb = 0; mb < 2; ++mb) {
    bf16x8 vf[4][2][2];
    { bf16x8 wfr[2][4];
#pragma unroll
      for (int part = 0; part < 2; ++part)
#pragma unroll
        for (int s = 0; s < 4; ++s) wfr[part][s] = *(const bf16x8*)(WcT + (64 * part + 32 * mb + r) * 64 + 16 * s + 8 * hh);
#pragma unroll
      for (int rb = 0; rb < 4; ++rb) { const size_t token = (size_t)b * 16384 + 128 * (32 * rb + r) + n2; bf16x8 uf[4];
#pragma unroll
        for (int s = 0; s < 4; ++s) uf[s] = *(const bf16x8*)(PM + token * LDPM + PM_AX + g * 64 + 16 * s + 8 * hh);
#pragma unroll
        for (int part = 0; part < 2; ++part) { f32x16 v = splat16(0.f);
#pragma unroll
          for (int s = 0; s < 4; ++s) v = MFMA32(uf[s], wfr[part][s], v);
          vf[rb][0][part] = pack8(v, 0); vf[rb][1][part] = pack8(v, 1); } } }
#pragma unroll 1
    for (int kq = 0; kq < 4; ++kq) {
      f32x16 Ar = splat16(0.f), Ai = splat16(0.f);
#pragma unroll
      for (int rb = 0; rb < 4; ++rb)
#pragma unroll
        for (int sx = 0; sx < 2; ++sx) { const int pos = (32 * kq + r) * 128 + 32 * rb + 16 * sx + 8 * hh;
          const bf16x8 cf = *(const bf16x8*)(CP + pos), sf = *(const bf16x8*)(SP + pos), nsf = *(const bf16x8*)(NSP + pos);
          Ar = MFMA32(cf, vf[rb][sx][0], Ar); Ar = MFMA32(sf, vf[rb][sx][1], Ar);
          Ai = MFMA32(cf, vf[rb][sx][1], Ai); Ai = MFMA32(nsf, vf[rb][sx][0], Ai); }
#pragma unroll
      for (int i = 0; i < 16; ++i) { const int k1 = 32 * kq + crow(i, hh); const float rev = (float)(n2 * k1) * (1.f / 16384.f); const float cs = cosrev(rev), sn = sinrev(rev);
        const float ar = Ar[i] * cs + Ai[i] * sn, ai = Ai[i] * cs - Ar[i] * sn;
        const size_t o = ((((size_t)b * 128 + k1) * 6 + g) * 128 + n2) * 128 + 32 * mb + r; AP[o] = f2bf(ar); AP[o + 64] = f2bf(ai); }
    }
  }
}

DI void fourierB_item(const Params& p, int b, int k1, int g, lds8* lds) {
  const int tid = launder_tid(), lane = tid & 63, w = tid >> 6, r = lane & 31, hh = lane >> 5, mb = w & 1, kq = w >> 1;
  const bf16_t* X = (const bf16_t*)(p.ws + OFF_AP) + (((size_t)b * 128 + k1) * 6 + g) * 16384;
  const bf16_t* CN = (const bf16_t*)(p.ws + OFF_TAB) + 8192 + 3 * 16384; const bf16_t* SN = CN + 16384; bf16_t* Y = (bf16_t*)(p.ws + OFF_Y);
#pragma unroll
  for (int i = 0; i < 4; ++i) { const int e = tid + NT * i, row = e >> 4, ch = e & 15; *(LAS u32x4*)(lds + row * 272 + ch * 16) = *(const u32x4*)(X + row * 128 + ch * 8); }
  __syncthreads();
  f32x16 F = splat16(0.f);
#pragma unroll
  for (int s = 0; s < 8; ++s) {
    const bf16x8 cf = *(const bf16x8*)(CN + (32 * kq + r) * 128 + 16 * s + 8 * hh), sf = *(const bf16x8*)(SN + (32 * kq + r) * 128 + 16 * s + 8 * hh);
    bf16x8 xr, xi;
#pragma unroll
    for (int j = 0; j < 8; ++j) { const int row = 16 * s + 8 * hh + j; xr[j] = *(const LAS short*)(lds + row * 272 + (32 * mb + r) * 2); xi[j] = *(const LAS short*)(lds + row * 272 + (64 + 32 * mb + r) * 2); }
    F = MFMA32(cf, xr, F); F = MFMA32(sf, xi, F);
  }
#pragma unroll
  for (int i = 0; i < 16; ++i) { const int k2 = 32 * kq + crow(i, hh); const size_t idx = ((size_t)b * 16384 + k1 + 128 * k2) * LDY + Y_A + g * 64 + 32 * mb + r;
    Y[idx] = f2bf(F[i] * (1.f / 1024.f) * bf2f(Y[idx])); }
  __syncthreads();
}

DI void fourierB_wave(const Params& p, int b, int k1, int g, int mb, int w, int lane, lds8* lds) {
  const int r = lane & 31, hh = lane >> 5;
  const bf16_t* X = (const bf16_t*)(p.ws + OFF_AP) + (((size_t)b * 128 + k1) * 6 + g) * 16384;
  const bf16_t* CN = (const bf16_t*)(p.ws + OFF_TAB) + 8192 + 3 * 16384; const bf16_t* SN = CN + 16384; bf16_t* Y = (bf16_t*)(p.ws + OFF_Y);
  lds8* slab = lds + w * 17408;
#pragma unroll
  for (int i = 0; i < 16; ++i) { const int e = lane + 64 * i, row = e >> 3, c = e & 7;
    const u32x4 v = *(const u32x4*)(X + row * 128 + (c < 4 ? 32 * mb + c * 8 : 64 + 32 * mb + (c - 4) * 8));
    *(LAS u32x2*)(slab + row * 136 + c * 16) = (u32x2){v.x, v.y}; *(LAS u32x2*)(slab + row * 136 + c * 16 + 8) = (u32x2){v.z, v.w}; }
  bf16x8 xr[8], xi[8];
#pragma unroll
  for (int s = 0; s < 8; ++s)
#pragma unroll
    for (int j = 0; j < 8; ++j) { const int row = 16 * s + 8 * hh + j; xr[s][j] = *(const LAS short*)(slab + row * 136 + r * 2); xi[s][j] = *(const LAS short*)(slab + row * 136 + 64 + r * 2); }
#pragma unroll 1
  for (int kq = 0; kq < 4; ++kq) {
    f32x16 F = splat16(0.f);
#pragma unroll
    for (int s = 0; s < 8; ++s) {
      const bf16x8 cf = *(const bf16x8*)(CN + (32 * kq + r) * 128 + 16 * s + 8 * hh), sf = *(const bf16x8*)(SN + (32 * kq + r) * 128 + 16 * s + 8 * hh);
      F = MFMA32(cf, xr[s], F); F = MFMA32(sf, xi[s], F); }
#pragma unroll
    for (int i = 0; i < 16; ++i) { const int k2 = 32 * kq + crow(i, hh); const size_t idx = ((size_t)b * 16384 + k1 + 128 * k2) * LDY + Y_A + g * 64 + 32 * mb + r;
      Y[idx] = f2bf(F[i] * (1.f / 1024.f) * bf2f(Y[idx])); }
  }
}

DI void fourierC_item(const Params& p, int b, int g, int kc, lds8* lds) {
  const int tid = launder_tid();
  LAS float* V = (LAS float*)lds; LAS float* T64c = V + 32768; LAS float* T64s = T64c + 64; LAS float* T256c = T64s + 64; LAS float* T256s = T256c + 256;
  const bf16_t* PM = (const bf16_t*)(p.ws + OFF_PM); bf16_t* Y = (bf16_t*)(p.ws + OFF_Y);
  if (tid < 64) { T64c[tid] = cosrev((float)tid * (1.f / 64.f)); T64s[tid] = sinrev((float)tid * (1.f / 64.f)); }
  if (tid < 256) { T256c[tid] = cosrev((float)tid * (1.f / 256.f)); T256s[tid] = sinrev((float)tid * (1.f / 256.f)); }
  __syncthreads();
  for (int e = tid; e < 32768; e += NT) { const int n = e >> 7, mp = e & 127, m = mp & 63;
    const bf16_t* up = PM + (size_t)(TL + b * 256 + n) * LDPM + PM_AX + g * 64; float a = 0.f;
    for (int c8 = 0; c8 < 64; c8 += 8) { float u[8]; unpack8(*(const u32x4*)(up + c8), u);
#pragma unroll
      for (int j = 0; j < 8; ++j) { const int t = (m * (c8 + j)) & 63; a += u[j] * (mp < 64 ? T64c[t] : -T64s[t]); } }
    V[e] = a; }
  __syncthreads();
#pragma unroll
  for (int i = 0; i < 4; ++i) { const int e = tid + NT * i; const int k = kc * 32 + (e >> 6), m = e & 63; float a = 0.f;
    for (int n = 0; n < 256; ++n) { const int t = (k * n) & 255; a += T256c[t] * V[n * 128 + m] + T256s[t] * V[n * 128 + 64 + m]; }
    const size_t idx = (size_t)(TL + b * 256 + k) * LDY + Y_A + g * 64 + m; Y[idx] = f2bf(a * (1.f / 128.f) * bf2f(Y[idx])); }
  __syncthreads();
}

DI void fourierC_stage1(const Params& p, lds8* lds) {
  const int tid = launder_tid(); LAS float* T = (LAS float*)lds;
  const bf16_t* PM = (const bf16_t*)(p.ws + OFF_PM); float* VC = (float*)(p.ws + OFF_VC);
  __syncthreads();
  if (tid < 64) { T[tid] = cosrev((float)tid * (1.f / 64.f)); T[64 + tid] = sinrev((float)tid * (1.f / 64.f)); }
  __syncthreads();
  for (int e = blockIdx.x * NT + tid; e < 2 * 256 * 6 * 128; e += gridDim.x * NT) {
    const int mp = e & 127, g = (e >> 7) % 6, n = (e / 768) & 255, b = e / (768 * 256), m = mp & 63;
    const bf16_t* up = PM + (size_t)(TL + b * 256 + n) * LDPM + PM_AX + g * 64; float a = 0.f;
    for (int c8 = 0; c8 < 64; c8 += 8) { float u[8]; unpack8(*(const u32x4*)(up + c8), u);
#pragma unroll
      for (int j = 0; j < 8; ++j) { const int t = (m * (c8 + j)) & 63; a += u[j] * (mp < 64 ? T[t] : -T[64 + t]); } }
    VC[e] = a; }
  __syncthreads();
}
DI void fourierC_stage2(const Params& p, lds8* lds) {
  const int tid = launder_tid(); LAS float* T = (LAS float*)lds;
  const float* VC = (const float*)(p.ws + OFF_VC); bf16_t* Y = (bf16_t*)(p.ws + OFF_Y);
  __syncthreads();
  if (tid < 256) { T[tid] = cosrev((float)tid * (1.f / 256.f)); T[256 + tid] = sinrev((float)tid * (1.f / 256.f)); }
  __syncthreads();
  for (int e = blockIdx.x * NT + tid; e < 2 * 256 * 6 * 64; e += gridDim.x * NT) {
    const int m = e & 63, g = (e >> 6) % 6, k = (e / 384) & 255, b = e / (384 * 256);
    const float* vp = VC + ((size_t)(b * 256) * 6 + g) * 128 + m; float a = 0.f;
#pragma unroll 8
    for (int n = 0; n < 256; ++n) { const int t = (k * n) & 255; a += T[t] * vp[(size_t)n * 768] + T[256 + t] * vp[(size_t)n * 768 + 64]; }
    const size_t idx = (size_t)(TL + b * 256 + k) * LDY + Y_A + g * 64 + m; Y[idx] = f2bf(a * (1.f / 128.f) * bf2f(Y[idx])); }
  __syncthreads();
}

DI void q_prep(bf16x8 (&qf)[4], const float* __restrict__ gain, bool rope, int prow, int pcol, int hh, const float* __restrict__ RT) {
  float y[4][8]; float ss = 0.f;
#pragma unroll
  for (int s = 0; s < 4; ++s)
#pragma unroll
    for (int j = 0; j < 8; ++j) { y[s][j] = bf2f((bf16_t)qf[s][j]); ss += y[s][j] * y[s][j]; }
  ss = sum32(ss);
  const float rs = rsqrtf(ss * (1.f / 64.f) + 1e-6f);
#pragma unroll
  for (int s = 0; s < 4; ++s) { const f32x4 g0 = *(const f32x4*)(gain + 16 * s + 8 * hh), g1 = *(const f32x4*)(gain + 16 * s + 8 * hh + 4);
    y[s][0] *= rs * g0[0]; y[s][1] *= rs * g0[1]; y[s][2] *= rs * g0[2]; y[s][3] *= rs * g0[3]; y[s][4] *= rs * g1[0]; y[s][5] *= rs * g1[1]; y[s][6] *= rs * g1[2]; y[s][7] *= rs * g1[3]; }
  if (rope) {
    const f32x4* cr = (const f32x4*)(RT + 2 * (prow * 16 + 8 * hh)); const f32x4* cc = (const f32x4*)(RT + 2 * (pcol * 16 + 8 * hh));
#pragma unroll
    for (int q = 0; q < 4; ++q) { const f32x4 a4 = cr[q], b4 = cc[q];
#pragma unroll
      for (int e = 0; e < 2; ++e) { const int jj = 2 * q + e; const float c1 = a4[2 * e], s1 = a4[2 * e + 1], c2 = b4[2 * e], s2 = b4[2 * e + 1];
        const float t1 = y[0][jj], t2 = y[1][jj], t3 = y[2][jj], t4 = y[3][jj];
        y[0][jj] = t1 * c1 - t2 * s1; y[1][jj] = t2 * c1 + t1 * s1; y[2][jj] = t3 * c2 - t4 * s2; y[3][jj] = t4 * c2 + t3 * s2; } }
  }
#pragma unroll
  for (int s = 0; s < 4; ++s) { u32x4 w; w.x = pk2(y[s][0] * QSCALE, y[s][1] * QSCALE); w.y = pk2(y[s][2] * QSCALE, y[s][3] * QSCALE); w.z = pk2(y[s][4] * QSCALE, y[s][5] * QSCALE); w.w = pk2(y[s][6] * QSCALE, y[s][7] * QSCALE);
    qf[s] = __builtin_bit_cast(bf16x8, w); }
}

constexpr int KP = 144;
template <int NDB>
DI void attn_tile(const lds8* kb_, const lds8* vb_, const bf16x8 (&qf)[4], f32x16 (&O)[NDB], float& lsum, float negM, int mmode, int qi, int koff, int r, int pr, int hh) {
  f32x16 S[2];
#pragma unroll
  for (int kb = 0; kb < 2; ++kb) { S[kb] = splat16(negM);
#pragma unroll
    for (int s = 0; s < 4; ++s) { const bf16x8 kf = *(const LAS bf16x8*)(kb_ + (32 * kb + pr) * KP + (16 * s + 8 * hh) * 2); S[kb] = MFMA32(kf, qf[s], S[kb]); } }
  if (mmode != 0) {
#pragma unroll
    for (int kb = 0; kb < 2; ++kb)
#pragma unroll
      for (int i = 0; i < 16; ++i) { const int kj = koff + 32 * kb + 16 * (i >> 3) + 8 * hh + (i & 7); const bool ok = mmode == 1 ? (kj >= qi) : (kj <= qi); if (!ok) S[kb][i] = -1e30f; }
  }
#pragma unroll
  for (int kb = 0; kb < 2; ++kb)
#pragma unroll
    for (int i = 0; i < 16; ++i) { const float pv = __builtin_amdgcn_exp2f(S[kb][i]); lsum += pv; S[kb][i] = pv; }
#pragma unroll
  for (int kb = 0; kb < 2; ++kb)
#pragma unroll
    for (int s = 0; s < 2; ++s) { const bf16x8 pf = pack8(S[kb], s);
#pragma unroll
      for (int db = 0; db < NDB; ++db) { const bf16x8 vfr = *(const LAS bf16x8*)(vb_ + (32 * db + r) * KP + (32 * kb + 16 * s + 8 * hh) * 2); O[db] = MFMA32(vfr, pf, O[db]); } }
}

DI float gain_max(const float* g, int lane) { float v = fabsf(g[lane]);
  v = wave_max(v);
  return v; }

constexpr int DSTG = 65536;
DI void attn_diff_item(const Params& p, int l, int b, int h, int qb, bool ctxq, lds8* lds) {
  const int tid = launder_tid(), lane = tid & 63, w = tid >> 6, r = lane & 31, hh = lane >> 5;
  const int pr = (r & ~12) | ((r & 4) << 1) | ((r & 8) >> 1);
  const bf16_t* PM = (const bf16_t*)(p.ws + OFF_PM); const bf16_t* VTD = (const bf16_t*)(p.ws + OFF_VTD); bf16_t* Y = (bf16_t*)(p.ws + OFF_Y);
  const size_t qrow = (size_t)(ctxq ? TL + b * 256 : b * 16384) + qb * 256 + w * 32 + r;
  bf16x8 qf[2][4];
#pragma unroll
  for (int c = 0; c < 2; ++c)
#pragma unroll
    for (int s = 0; s < 4; ++s) qf[c][s] = *(const bf16x8*)(PM + qrow * LDPM + PM_DQ + h * 128 + c * 64 + 16 * s + 8 * hh);
  { const int nq = (int)qrow & 16383; const float* RTq = (const float*)(p.ws + OFF_ROPE);
    q_prep(qf[0], p.q_norm_d + l * 64, !ctxq, nq >> 6, nq & 63, hh, RTq); q_prep(qf[1], p.q_norm_d + l * 64, !ctxq, nq >> 6, nq & 63, hh, RTq); }
  f32x16 O1[4], O2[4];
#pragma unroll
  for (int d = 0; d < 4; ++d) { O1[d] = splat16(0.f); O2[d] = splat16(0.f); }
  float ls1 = 0.f, ls2 = 0.f;
  const int nt = ctxq ? 2 : 130;
  const char* kbu = (const char*)(PM + (size_t)(TL + b * 256) * LDPM + PM_DK + h * 128);
  const char* kbu_lat = (const char*)(PM + (size_t)(b * 16384) * LDPM + PM_DK + h * 128);
  const char* vbu = (const char*)(VTD + (size_t)(b * 4 + h) * 128 * NKEY);
#define DSTAGE(buf_) do { const int t_ = launder_tid(); const int lr_ = t_ >> 3, lc_ = (t_ & 7) ^ ((lr_ >> 1) & 7), vr_ = t_ >> 4, vc_ = (t_ & 15) ^ (vr_ & 15); \
    const unsigned kvo = (unsigned)((lr_ * LDPM + lc_ * 8) * 2), vvo = (unsigned)((vr_ * NKEY + vc_ * 8) * 2); lds8* b__ = lds + t_ * 16 + (buf_) * DSTG; \
    __builtin_amdgcn_global_load_lds((const unsigned*)(kbu + kvo), (LAS unsigned*)b__, 16, 0, 0); __builtin_amdgcn_sched_barrier(0); \
    __builtin_amdgcn_global_load_lds((const unsigned*)(kbu + (size_t)64 * LDPM * 2 + kvo), (LAS unsigned*)(b__ + 8192), 16, 0, 0); __builtin_amdgcn_sched_barrier(0); \
    __builtin_amdgcn_global_load_lds((const unsigned*)(kbu + 128 + kvo), (LAS unsigned*)(b__ + 16384), 16, 0, 0); __builtin_amdgcn_sched_barrier(0); \
    __builtin_amdgcn_global_load_lds((const unsigned*)(kbu + (size_t)64 * LDPM * 2 + 128 + kvo), (LAS unsigned*)(b__ + 24576), 16, 0, 0); __builtin_amdgcn_sched_barrier(0); \
    __builtin_amdgcn_global_load_lds((const unsigned*)(vbu + vvo), (LAS unsigned*)(b__ + 32768), 16, 0, 0); __builtin_amdgcn_sched_barrier(0); \
    __builtin_amdgcn_global_load_lds((const unsigned*)(vbu + (size_t)32 * NKEY * 2 + vvo), (LAS unsigned*)(b__ + 40960), 16, 0, 0); __builtin_amdgcn_sched_barrier(0); \
    __builtin_amdgcn_global_load_lds((const unsigned*)(vbu + (size_t)64 * NKEY * 2 + vvo), (LAS unsigned*)(b__ + 49152), 16, 0, 0); __builtin_amdgcn_sched_barrier(0); \
    __builtin_amdgcn_global_load_lds((const unsigned*)(vbu + (size_t)96 * NKEY * 2 + vvo), (LAS unsigned*)(b__ + 57344), 16, 0, 0); __builtin_amdgcn_sched_barrier(0); \
    kbu += (size_t)128 * LDPM * 2; vbu += 256; } while (0)
  const int ksw = (pr >> 1) & 7, vsw = r & 15;
  int koff[4], voff[2];
#pragma unroll
  for (int s = 0; s < 4; ++s) koff[s] = pr * 128 + (((2 * s + hh) ^ ksw) << 4);
#pragma unroll
  for (int s = 0; s < 2; ++s) voff[s] = r * 256 + (((2 * s + hh) ^ vsw) << 4);
#define DBODY(cur_) do { \
    _Pragma("unroll 1") for (int kb = 0; kb < 4; ++kb) { \
      __builtin_amdgcn_iglp_opt(0); \
      bf16x8 P1[2], P2[2]; \
      _Pragma("unroll") for (int c = 0; c < 2; ++c) { \
        f32x16 S = splat16(0.f); \
        _Pragma("unroll") for (int s = 0; s < 4; ++s) { const bf16x8 kf = *(const LAS bf16x8*)(lds + c * 16384 + kb * 4096 + koff[s]); S = MFMA32(kf, qf[c][s], S); } \
        float ls = 0.f; \
        _Pragma("unroll") for (int i = 0; i < 16; ++i) { const float pv = __builtin_amdgcn_exp2f(S[i]); ls += pv; S[i] = pv; } \
        if (c == 0) { ls1 += ls; P1[0] = pack8(S, 0); P1[1] = pack8(S, 1); } else { ls2 += ls; P2[0] = pack8(S, 0); P2[1] = pack8(S, 1); } \
      } \
      _Pragma("unroll") for (int s = 0; s < 2; ++s) { \
        _Pragma("unroll") for (int db = 0; db < 4; ++db) { const bf16x8 vfr = *(const LAS bf16x8*)(lds + 32768 + db * 8192 + (voff[s] ^ (kb << 6))); \
          O1[db] = MFMA32(vfr, P1[s], O1[db]); O2[db] = MFMA32(vfr, P2[s], O2[db]); } } \
    } \
    _Pragma("unroll") for (int s = 0; s < 4; ++s) { koff[s] ^= DSTG; asm volatile("" : "+v"(koff[s])); } \
    _Pragma("unroll") for (int s = 0; s < 2; ++s) { voff[s] ^= DSTG; asm volatile("" : "+v"(voff[s])); } \
  } while (0)
  DSTAGE(0);
  asm volatile("s_waitcnt vmcnt(0)" ::: "memory"); __syncthreads();
#pragma unroll 1
  for (int t = 0; t < nt; t += 2) {
    DSTAGE(1);
    if (t + 2 == 2) kbu = kbu_lat;
    DBODY(0);
    asm volatile("s_waitcnt vmcnt(0)" ::: "memory"); __syncthreads();
    if (t + 2 < nt) DSTAGE(0);
    DBODY(1);
    asm volatile("s_waitcnt vmcnt(0)" ::: "memory"); __syncthreads();
  }
#undef DSTAGE
#undef DBODY
  const int tid2 = launder_tid(), lane2 = tid2 & 63, w2 = tid2 >> 6, r2 = lane2 & 31, hh2 = lane2 >> 5;
  const size_t qrow2 = (size_t)(ctxq ? TL + b * 256 : b * 16384) + qb * 256 + w2 * 32 + r2;
  ls1 = sum32(ls1); ls2 = sum32(ls2);
  float la = p.lam_q1[l * 64 + lane2] * p.lam_k1[l * 64 + lane2], lb = p.lam_q2[l * 64 + lane2] * p.lam_k2[l * 64 + lane2];
  la = wave_sum(la); lb = wave_sum(lb);
  const float lam_init = l == 0 ? 0.2f : (0.8f - 0.6f * 0.7408182206817179f);
  const float lam = __expf(la) - __expf(lb) + lam_init;
  const float i1 = 1.f / ls1, i2 = lam / ls2;
  float ss = 0.f;
#pragma unroll
  for (int d = 0; d < 4; ++d)
#pragma unroll
    for (int i = 0; i < 16; ++i) { const float o = O1[d][i] * i1 - O2[d][i] * i2; O1[d][i] = o; ss += o * o; }
  ss = sum32(ss);
  const float rs = rsqrtf(ss * (1.f / 128.f) + 1e-6f) * (1.f - lam_init);
  const float* sg = p.subln_d + l * 128;
  bf16_t* yrow = (bf16_t*)(p.ws + OFF_Y) + qrow2 * LDY + Y_D + h * 128;
#pragma unroll
  for (int d = 0; d < 4; ++d)
#pragma unroll
    for (int a = 0; a < 4; ++a) { const int dv = 32 * d + 8 * a + 4 * hh2; const u32x2 szr = *(const u32x2*)(yrow + dv); const f32x4 g4 = *(const f32x4*)(sg + dv);
      u32x2 o; o.x = pk2(O1[d][4 * a + 0] * rs * g4[0] * bflo(szr.x), O1[d][4 * a + 1] * rs * g4[1] * bfhi(szr.x));
      o.y = pk2(O1[d][4 * a + 2] * rs * g4[2] * bflo(szr.y), O1[d][4 * a + 3] * rs * g4[3] * bfhi(szr.y)); *(u32x2*)(yrow + dv) = o; }
  __syncthreads();
}

constexpr int SSTG = 18432;
DI void attn_swa_item(const Params& p, int l, int b, int hk, int blk, bool ctxq, lds8* lds) {
  const int tid = launder_tid(), lane = tid & 63, w = tid >> 6, r = lane & 31, hh = lane >> 5, rg = w & 3, hp = w >> 2;
  const int pr = (r & ~12) | ((r & 4) << 1) | ((r & 8) >> 1);
  const bf16_t* PM = (const bf16_t*)(p.ws + OFF_PM); const bf16_t* VTB = (const bf16_t*)(p.ws + OFF_VTB); bf16_t* Y = (bf16_t*)(p.ws + OFF_Y);
  constexpr float negM = 0.f;
  const size_t qrow = (size_t)(ctxq ? TL + b * 256 : b * 16384) + blk * 128 + rg * 32 + r;
  const int qi = rg * 32 + r;
  const int lrow = tid >> 3, lch = tid & 7;
  const bf16_t* vbase = VTB + ((size_t)(b * 2 + hk) * 64 + lrow) * NKEY + lch * 8;
  const int nt = ctxq ? 4 : 10;
  {
    const int hq = hk * 4 + hp * 2;
    bf16x8 qf0[4], qf1[4];
#pragma unroll
    for (int s = 0; s < 4; ++s) { qf0[s] = *(const bf16x8*)(PM + qrow * LDPM + PM_BQ + hq * 64 + 16 * s + 8 * hh); qf1[s] = *(const bf16x8*)(PM + qrow * LDPM + PM_BQ + (hq + 1) * 64 + 16 * s + 8 * hh); }
    { const int nq = (int)qrow & 16383; const float* RTq = (const float*)(p.ws + OFF_ROPE);
      q_prep(qf0, p.q_norm_b + l * 64, !ctxq, nq >> 6, nq & 63, hh, RTq); q_prep(qf1, p.q_norm_b + l * 64, !ctxq, nq >> 6, nq & 63, hh, RTq); }
    f32x16 O0[2], O1[2]; O0[0] = splat16(0.f); O0[1] = splat16(0.f); O1[0] = splat16(0.f); O1[1] = splat16(0.f);
    float ls0 = 0.f, ls1 = 0.f;
#define SWA_VALID(t_) ((t_) < 4 || (t_) == 6 || (t_) == 7 || ((t_) < 6 ? blk > 0 : blk < 127))
#define SWA_LOAD(t_) do { const int t__ = (t_); int krow0, key0; \
      if (t__ < 4) { krow0 = TL + b * 256 + t__ * 64; key0 = t__ * 64; } \
      else { const int bb = blk + ((t__ - 4) >> 1) - 1; const int nn = bb * 128 + ((t__ - 4) & 1) * 64; krow0 = b * 16384 + nn; key0 = 256 + nn; } \
      st0 = *(const u32x4*)(PM + (size_t)(krow0 + lrow) * LDPM + PM_BK + hk * 64 + lch * 8); st1 = *(const u32x4*)(vbase + key0); } while (0)
    u32x4 st0, st1; int t = 0, cur = 0;
    SWA_LOAD(0);
#pragma unroll 1
    while (t < nt) {
      lds8* bb_ = lds + cur * SSTG;
      *(LAS u32x4*)(bb_ + lrow * KP + lch * 16) = st0; *(LAS u32x4*)(bb_ + 9216 + lrow * KP + lch * 16) = st1;
      __syncthreads();
      int tn = t + 1; while (tn < nt && !SWA_VALID(tn)) ++tn;
      if (tn < nt) SWA_LOAD(tn);
      const int mmode = t < 4 ? 0 : (t < 6 ? 1 : (t < 8 ? 0 : 2)); const int koff = t < 4 ? 0 : ((t - 4) & 1) * 64;
      attn_tile<2>(bb_, bb_ + 9216, qf0, O0, ls0, negM, mmode, qi, koff, r, pr, hh);
      __builtin_amdgcn_sched_barrier(0);
      attn_tile<2>(bb_, bb_ + 9216, qf1, O1, ls1, negM, mmode, qi, koff, r, pr, hh);
      __builtin_amdgcn_sched_barrier(0);
      cur ^= 1; t = tn;
    }
#undef SWA_VALID
#undef SWA_LOAD
    ls0 = sum32(ls0); ls1 = sum32(ls1);
    ls0 += __builtin_amdgcn_exp2f(p.sink_b[l * 8 + hq] * LOG2E); ls1 += __builtin_amdgcn_exp2f(p.sink_b[l * 8 + hq + 1] * LOG2E);
    const float i0 = 1.f / ls0, i1 = 1.f / ls1;
    bf16_t* yrow = Y + qrow * LDY + Y_B + hq * 64;
#pragma unroll
    for (int d = 0; d < 2; ++d)
#pragma unroll
      for (int a = 0; a < 4; ++a) { const int dv = 32 * d + 8 * a + 4 * hh;
        { const u32x2 szr = *(const u32x2*)(yrow + dv); u32x2 o; o.x = pk2(O0[d][4 * a + 0] * i0 * bflo(szr.x), O0[d][4 * a + 1] * i0 * bfhi(szr.x)); o.y = pk2(O0[d][4 * a + 2] * i0 * bflo(szr.y), O0[d][4 * a + 3] * i0 * bfhi(szr.y)); *(u32x2*)(yrow + dv) = o; }
        { const u32x2 szr = *(const u32x2*)(yrow + 64 + dv); u32x2 o; o.x = pk2(O1[d][4 * a + 0] * i1 * bflo(szr.x), O1[d][4 * a + 1] * i1 * bfhi(szr.x)); o.y = pk2(O1[d][4 * a + 2] * i1 * bflo(szr.y), O1[d][4 * a + 3] * i1 * bfhi(szr.y)); *(u32x2*)(yrow + 64 + dv) = o; } }
    __syncthreads();
  }
}

DI void phase_elem(const Params& p, int l, lds8* lds) {
  const int tid = launder_tid(), lane = tid & 63, w = tid >> 6;
  normrope_phase(p, l, w, lane);
  for (int it = blockIdx.x * NT + tid; it < TT * 48; it += gridDim.x * NT) conv_item(p, l, it);
  for (int it = blockIdx.x; it < 1536; it += gridDim.x) { const int g = it % 6, n2 = (it / 6) % 128, b = it / 768; fourierA_item(p, b, n2, g); }
  if (l == 0) for (int it = blockIdx.x; it < 96; it += gridDim.x) { const int kc = it & 7, g = (it >> 3) % 6, b = it / 48; fourierC_item(p, b, g, kc, lds); }
}

DI void phase_mix(const Params& p, int l, lds8* lds) {
  for (int it = blockIdx.x; it < 512; it += gridDim.x) { const int bh = it & 7, qb = it >> 3; attn_diff_item(p, l, bh >> 2, bh & 3, qb, false, lds); }
  for (int it = blockIdx.x; it < 512; it += gridDim.x) { const int bk = it & 3, blk = it >> 2; attn_swa_item(p, l, bk >> 1, bk & 1, blk, false, lds); }
  for (int it = blockIdx.x; it < 1536; it += gridDim.x) { const int g = it % 6, k1 = (it / 6) % 128, b = it / 768; fourierB_item(p, b, k1, g, lds); }
  if (l == 0) {
    for (int it = blockIdx.x; it < 8; it += gridDim.x) { const int bh = it & 7; attn_diff_item(p, l, bh >> 2, bh & 3, 0, true, lds); }
    for (int it = blockIdx.x; it < 8; it += gridDim.x) { const int bk = it & 3, blk = it >> 2; attn_swa_item(p, l, bk >> 1, bk & 1, blk, true, lds); }
  }
}

struct GateCtx {
  const Params& p; int G, bid, l;
  int u, sub;
  DI bool next(int, g8::Desc& d) {
    int pm, pn; bool ctx = false;
    if (u < 2) unit_next(128, 4, u * G + bid, pm, pn);
    else return false;
    const int br = sub >> 1;
    d.pm = pm; d.pn = pn; d.aux = sub | (ctx ? 8 : 0);
    if ((sub & 1) == 0) { d.A = (const char*)(p.ws + OFF_H) + (size_t)pm * 256 * 1024 * 2; d.B = (const char*)(p.ws + OFF_WIN) + (size_t)(5632 + br * 1024 + pn * 256) * 1024 * 2; d.lda = 1024; d.ldb = 1024; d.nt = 16; }
    else { const int Kb = (br & 1) ? 512 : 384; const int ycol = br == 0 ? Y_A : (br == 1 ? Y_B : (br == 2 ? Y_C : Y_D));
      const size_t wooff = br == 0 ? 0 : (br == 1 ? 393216 : (br == 2 ? 917504 : 1310720));
      d.A = (const char*)(p.ws + OFF_Y) + ((size_t)pm * 256 * LDY + ycol) * 2; d.B = (const char*)(p.ws + OFF_WO) + (wooff + (size_t)pn * 256 * Kb) * 2; d.lda = LDY; d.ldb = Kb; d.nt = Kb / 64; }
    sub += ctx ? 2 : 1; if (sub >= 8) { sub = 0; ++u; }
    return true; }
  DI void epi(const g8::Desc& d, const f32x4 (&acc)[2][2][4][2]) const {
    const int tid2 = launder_tid();
    u32x2* SGt = (u32x2*)(p.ws + OFF_SCR + (size_t)bid * 393216) + tid2; u32x2* SMt = (u32x2*)(p.ws + OFF_SCR + (size_t)bid * 393216 + 131072) + tid2;
    const int br = (d.aux & 7) >> 1; const bool ctxg = (d.aux & 8) != 0;
    if ((d.aux & 1) == 0) {
#pragma unroll
      for (int ai = 0; ai < 2; ++ai)
#pragma unroll
        for (int bj = 0; bj < 2; ++bj)
#pragma unroll
          for (int m = 0; m < 4; ++m)
#pragma unroll
            for (int n = 0; n < 2; ++n) { const int slot = ((ai * 2 + bj) * 4 + m) * 2 + n; const f32x4 v = acc[ai][bj][m][n];
              u32x2 o; o.x = pk2(sigm(v[0]), sigm(v[1])); o.y = pk2(sigm(v[2]), sigm(v[3])); SGt[slot * NT] = o; }
    } else {
      bf16_t* MIXED = (bf16_t*)(p.ws + OFF_MIXED);
      const int wid2 = tid2 >> 6, lane2 = tid2 & 63, wr2 = wid2 >> 2, wc2 = wid2 & 3, fr2 = lane2 & 15, fq2 = lane2 >> 4;
#pragma unroll
      for (int ai = 0; ai < 2; ++ai)
#pragma unroll
        for (int bj = 0; bj < 2; ++bj)
#pragma unroll
          for (int m = 0; m < 4; ++m)
#pragma unroll
            for (int n = 0; n < 2; ++n) { const int slot = ((ai * 2 + bj) * 4 + m) * 2 + n; const f32x4 v = acc[ai][bj][m][n];
              const int row_ = d.pm * 256 + ai * 128 + wr2 * 64 + m * 16 + fr2, col_ = d.pn * 256 + bj * 128 + wc2 * 32 + n * 16 + fq2 * 4;
              const u32x2 gg = ctxg ? *(const u32x2*)((const bf16_t*)(p.ws + OFF_CG) + (size_t)(row_ - TL) * 4096 + br * 1024 + col_) : SGt[slot * NT]; f32x4 mm = {0.f, 0.f, 0.f, 0.f}; if (br > 0) { const u32x2 mr = SMt[slot * NT]; mm[0] = bflo(mr.x); mm[1] = bfhi(mr.x); mm[2] = bflo(mr.y); mm[3] = bfhi(mr.y); }
              mm[0] += bflo(gg.x) * v[0]; mm[1] += bfhi(gg.x) * v[1]; mm[2] += bflo(gg.y) * v[2]; mm[3] += bfhi(gg.y) * v[3];
              u32x2 mo; mo.x = pk2(mm[0], mm[1]); mo.y = pk2(mm[2], mm[3]);
              if (br < 3) SMt[slot * NT] = mo;
              else { const int row = d.pm * 256 + ai * 128 + wr2 * 64 + m * 16 + fr2, col = d.pn * 256 + bj * 128 + wc2 * 32 + n * 16 + fq2 * 4; *(u32x2*)(MIXED + (size_t)row * 1024 + col) = mo; } }
    }
  }
};
DI void ctx_merge_tasks(const Params& p) {
  const int tid = launder_tid(), lane = tid & 63, w = tid >> 6, r = lane & 31, hh = lane >> 5;
  const bf16_t* Y = (const bf16_t*)(p.ws + OFF_Y); const bf16_t* WO = (const bf16_t*)(p.ws + OFF_WO); const bf16_t* CG = (const bf16_t*)(p.ws + OFF_CG); bf16_t* MIXED = (bf16_t*)(p.ws + OFF_MIXED);
  for (int tk = w * gridDim.x + blockIdx.x; tk < 512; tk += 8 * gridDim.x) {
    const int rb = tk >> 5, cb = tk & 31;
    f32x16 mm = splat16(0.f);
#pragma unroll 1
    for (int br = 0; br < 4; ++br) {
      const int Kb = (br & 1) ? 512 : 384; const int ycol = br == 0 ? Y_A : (br == 1 ? Y_B : (br == 2 ? Y_C : Y_D));
      const size_t wooff = br == 0 ? 0 : (br == 1 ? 393216 : (br == 2 ? 917504 : 1310720));
      const bf16_t* ap = Y + (size_t)(TL + 32 * rb + r) * LDY + ycol + 8 * hh; const bf16_t* bp = WO + wooff + (size_t)(32 * cb + r) * Kb + 8 * hh;
      f32x16 acc = splat16(0.f);
#pragma unroll 4
      for (int s = 0; s < Kb / 16; ++s) acc = MFMA32(*(const bf16x8*)(ap + 16 * s), *(const bf16x8*)(bp + 16 * s), acc);
#pragma unroll
      for (int i = 0; i < 16; ++i) mm[i] += bf2f(CG[(size_t)(32 * rb + crow(i, hh)) * 4096 + br * 1024 + 32 * cb + r]) * acc[i];
    }
#pragma unroll
    for (int i = 0; i < 16; ++i) MIXED[(size_t)(TL + 32 * rb + crow(i, hh)) * 1024 + 32 * cb + r] = f2bf(mm[i]);
  }
}
DI void ctx_out_tasks(const Params& p) {
  const int tid = launder_tid(), lane = tid & 63, w = tid >> 6, r = lane & 31, hh = lane >> 5;
  const bf16_t* MIXED = (const bf16_t*)(p.ws + OFF_MIXED); const bf16_t* WOUT = (const bf16_t*)(p.ws + OFF_WOUT); const float* MOD = (const float*)(p.ws + OFF_MOD); float* CTX1 = (float*)(p.ws + OFF_CTX1);
  for (int tk = w * gridDim.x + blockIdx.x; tk < 512; tk += 8 * gridDim.x) {
    const int rb = tk >> 5, cb = tk & 31;
    const bf16_t* ap = MIXED + (size_t)(TL + 32 * rb + r) * 1024 + 8 * hh; const bf16_t* bp = WOUT + (size_t)(32 * cb + r) * 1024 + 8 * hh;
    f32x16 acc = splat16(0.f);
#pragma unroll 4
    for (int s = 0; s < 64; ++s) acc = MFMA32(*(const bf16x8*)(ap + 16 * s), *(const bf16x8*)(bp + 16 * s), acc);
    const float gt = MOD[2 * 3072 + 2048 + 32 * cb + r];
#pragma unroll
    for (int i = 0; i < 16; ++i) { const size_t o = (size_t)(32 * rb + crow(i, hh)) * 1024 + 32 * cb + r; CTX1[o] = p.ctx[o] + gt * acc[i]; }
  }
}
DI void phase_gate(const Params& p, int l, lds8* lds) { GateCtx c{p, (int)gridDim.x, (int)blockIdx.x, l, 0, 0}; g8::gemm_stream(lds, c); if (l == 0) ctx_merge_tasks(p); }

struct OutCtx {
  const Params& p; int G, bid, nM, l;
  DI bool next(int ui, g8::Desc& d) const {
    int pm, pn; if (!unit_next(nM, 4, ui * G + bid, pm, pn)) return false;
    d.A = (const char*)(p.ws + OFF_MIXED) + (size_t)pm * 256 * 1024 * 2; d.B = (const char*)(p.ws + OFF_WOUT) + ((size_t)l * 1048576 + (size_t)pn * 256 * 1024) * 2;
    d.lda = 1024; d.ldb = 1024; d.nt = 16; d.pm = pm; d.pn = pn; d.aux = 0; return true; }
  DI void epi(const g8::Desc& d, const f32x4 (&acc)[2][2][4][2]) const {
    const int tid = launder_tid(), wid = tid >> 6, lane = tid & 63, wr = wid >> 2, wc = wid & 3, fr = lane & 15, fq = lane >> 4;
    const float* MOD = (const float*)(p.ws + OFF_MOD); float* CTX1 = (float*)(p.ws + OFF_CTX1);
    const float* xl = l == 0 ? p.x : p.out;
#pragma unroll
    for (int ai = 0; ai < 2; ++ai)
#pragma unroll
      for (int m = 0; m < 4; ++m) { const int row = d.pm * 256 + ai * 128 + wr * 64 + m * 16 + fr;
        const float* src; float* dst; int v;
        if (row < TL) { src = xl + (size_t)row * 1024; dst = p.out + (size_t)row * 1024; v = row >> 14; } else { src = p.ctx + (size_t)(row - TL) * 1024; dst = CTX1 + (size_t)(row - TL) * 1024; v = 2; }
        const float* gate = MOD + (l * 3 + v) * 3072 + 2048;
#pragma unroll
        for (int bj = 0; bj < 2; ++bj)
#pragma unroll
          for (int n = 0; n < 2; ++n) { const int col = d.pn * 256 + bj * 128 + wc * 32 + n * 16 + fq * 4;
            const f32x4 xv = *(const f32x4*)(src + col), gv = *(const f32x4*)(gate + col); *(f32x4*)(dst + col) = xv + gv * acc[ai][bj][m][n]; } }
  }
};
DI void phase_out(const Params& p, int l, lds8* lds) { OutCtx c{p, (int)gridDim.x, (int)blockIdx.x, 128, l}; g8::gemm_stream(lds, c); if (l == 0) ctx_out_tasks(p); }

#define XB_TMO      128
#define XB_XCNT(j)  (256  + 64 * (j))
#define XB_XSUB(j)  (1280 + 64 * (j))
#define XB_XGEN(j)  (2304 + 64 * (j))
#define XB_TOP      3328
#define XB_TOPGEN   3392
#define XCD_BAR_WORDS 3456
#define XB_SPIN_CAP (1u << 20)
DI unsigned xb_ld(unsigned* p) { return __hip_atomic_load(p, __ATOMIC_RELAXED, __HIP_MEMORY_SCOPE_AGENT); }
DI unsigned xb_add(unsigned* p, unsigned v) { return __hip_atomic_fetch_add(p, v, __ATOMIC_RELAXED, __HIP_MEMORY_SCOPE_AGENT); }
DI unsigned xb_xcc_id() { return (unsigned)__builtin_amdgcn_s_getreg((3 << 11) | 20) & 0xFu; }
#define XB_SPIN(cond, bar) do { unsigned _sp = 0; while (cond) { __builtin_amdgcn_s_sleep(1); \
    if ((++_sp & 255u) == 0u) { if (xb_ld(&(bar)[XB_TMO])) break; if (_sp > XB_SPIN_CAP) { atomicAdd(&(bar)[XB_TMO], 1u); break; } } } } while (0)
struct XcdBarrier { unsigned* bar; unsigned x; volatile LAS unsigned* st; };
DI XcdBarrier xcd_barrier_post(unsigned* bar, volatile LAS unsigned* st) {
  XcdBarrier b; b.bar = bar; b.x = xb_xcc_id(); b.st = st;
  if (threadIdx.x == 0) (void)xb_add(&bar[XB_XCNT(b.x)], 1u);
  return b;
}
DI void xcd_barrier_complete(unsigned* bar, unsigned x, unsigned& nloc, unsigned& nx) {
  const unsigned G = gridDim.x * gridDim.y * gridDim.z;
  unsigned sum, cnt, mine, sp = 0u;
  for (;;) {
    sum = 0u; cnt = 0u; mine = 0u;
#pragma unroll
    for (unsigned j = 0; j < 16; ++j) { const unsigned c = xb_ld(&bar[XB_XCNT(j)]); sum += c; cnt += (c > 0u) ? 1u : 0u; mine = (j == x) ? c : mine; }
    if (sum == G) break;
    __builtin_amdgcn_s_sleep(1);
    if ((++sp & 255u) == 0u) { if (xb_ld(&bar[XB_TMO])) break; if (sp > XB_SPIN_CAP) { atomicAdd(&bar[XB_TMO], 1u); break; } }
  }
  nloc = mine > 0u ? mine : 1u; nx = cnt > 0u ? cnt : 1u;
}
DI void xcd_barrier(const XcdBarrier& b) {
  asm volatile("s_waitcnt vmcnt(0)" ::: "memory");
  __syncthreads();
  if (threadIdx.x == 0) {
    unsigned* bar = b.bar;
    __builtin_amdgcn_s_waitcnt(0);
    unsigned nloc = b.st[0], nx = b.st[1];
    if (nloc == 0u) { xcd_barrier_complete(bar, b.x, nloc, nx); b.st[0] = nloc; b.st[1] = nx; }
    const unsigned old = xb_add(&bar[XB_XSUB(b.x)], 1u);
    const unsigned gen = old / nloc;
    if (old + 1u == (gen + 1u) * nloc) {
      __builtin_amdgcn_fence(__ATOMIC_RELEASE, "agent");
      asm volatile("s_waitcnt vmcnt(0)" ::: "memory");
      const unsigned og = xb_add(&bar[XB_TOP], 1u);
      const unsigned tg = og / nx;
      if (og + 1u == (tg + 1u) * nx) xb_add(&bar[XB_TOPGEN], 1u);
      else XB_SPIN(xb_ld(&bar[XB_TOPGEN]) == tg, bar);
      __builtin_amdgcn_fence(__ATOMIC_ACQUIRE, "agent");
      xb_add(&bar[XB_XGEN(b.x)], 1u);
      asm volatile("s_waitcnt vmcnt(0)" ::: "memory");
    } else {
      XB_SPIN(xb_ld(&bar[XB_XGEN(b.x)]) == gen, bar);
      __builtin_amdgcn_fence(__ATOMIC_ACQUIRE, "agent");
      asm volatile("s_waitcnt vmcnt(0)" ::: "memory");
    }
  }
  __syncthreads();
}

DI int wg_dequeue(unsigned* ctr, lds8* lds) {
  volatile LAS int* slot = (volatile LAS int*)(lds + LDS_BYTES - 8);
  __syncthreads();
  if (threadIdx.x == 0) *slot = (int)__hip_atomic_fetch_add(ctr, 1u, __ATOMIC_RELAXED, __HIP_MEMORY_SCOPE_AGENT);
  __syncthreads();
  return *slot;
}

#ifndef PROBE_MODE
#define PROBE_MODE 0
#endif
#ifndef PROBE_A
#define PROBE_A 0x100
#endif
#ifndef PROBE_B
#define PROBE_B 0x1000
#endif
#if PROBE_MODE
DI unsigned long long ptime_() { unsigned long long t; asm volatile("s_memrealtime %0\n\ts_waitcnt lgkmcnt(0)" : "=s"(t) :: "memory"); return t; }
#define PTIME() ptime_()
#define PACC(cat, t0_) do { const unsigned long long d_ = PTIME() - (t0_); if ((PROBE_A >> (cat)) & 1) tA += d_; if ((PROBE_B >> (cat)) & 1) tB += d_; } while (0)
#else
#define PTIME() 0ull
#define PACC(cat, t0_) do { (void)(t0_); } while (0)
#endif

__global__ void __launch_bounds__(NT) hybrid_fwd(Params p) {
  extern __shared__ __attribute__((aligned(16))) unsigned char lds_raw[];
  lds8* lds = (lds8*)lds_raw;
  cg::grid_group grid = cg::this_grid();
  volatile LAS unsigned* xst = (volatile LAS unsigned*)(lds + LDS_BYTES - 16);
  if (threadIdx.x == 0) { xst[0] = 0u; xst[1] = 0u; }
  __syncthreads();
  if (blockIdx.x == 0) { unsigned* bw = (unsigned*)(p.ws + OFF_BAR); for (int i = threadIdx.x; i < 4096; i += NT) bw[i] = 0u; }
  unsigned long long tA = 0, tB = 0, tq; const unsigned long long tstart = PTIME();
  tq = PTIME();
  for (int it = blockIdx.x; it < PREP_ITEMS + 98; it += gridDim.x) {
    if (it < PREP_ITEMS) prep_item(p, 0, it, lds);
    else if (it < PREP_ITEMS + 96) mod_item(p, it - PREP_ITEMS, lds);
    else tables_item(p, it - PREP_ITEMS - 96);
  }
  grid.sync(); PACC(0, tq);
  const XcdBarrier xbar = xcd_barrier_post((unsigned*)(p.ws + OFF_BAR), xst);
#pragma unroll 1
  for (int l = 0; l < 2; ++l) {
    tq = PTIME(); phase_norm(p, l); xcd_barrier(xbar); PACC(1, tq);
    tq = PTIME(); phase_inproj(p, l, lds); xcd_barrier(xbar); PACC(2, tq);
    tq = PTIME();
    { const int tid_ = launder_tid(), lane_ = tid_ & 63, w_ = tid_ >> 6; unsigned long long t2 = PTIME();
      PACC(10, t2); t2 = PTIME();
      for (int it = blockIdx.x * NT + tid_; it < TT * 48; it += gridDim.x * NT) conv_item(p, l, it);
      PACC(11, t2); t2 = PTIME();
      for (int it = w_ * gridDim.x + blockIdx.x; it < 1536; it += 8 * gridDim.x) { const int g = it % 6, n2 = (it / 6) % 128, b = it / 768; fourierA_wave(p, b, n2, g, lane_); }
      PACC(12, t2); t2 = PTIME();
      if (l == 0) fourierC_stage1(p, lds);
      PACC(13, t2); }
    xcd_barrier(xbar); PACC(3, tq);
    tq = PTIME();
    { unsigned long long t2 = PTIME();
      for (int it = blockIdx.x; it < 512; it += gridDim.x) { const int bh = it & 7, qb = it >> 3; attn_diff_item(p, l, bh >> 2, bh & 3, qb, false, lds); }
      PACC(7, t2); t2 = PTIME();
      {
        unsigned* qctr = (unsigned*)(p.ws + OFF_BAR) + 3520 + 64 * l;
        for (int it = wg_dequeue(qctr, lds); it < 512; it = wg_dequeue(qctr, lds)) { const int bk = it & 3, blk = it >> 2; attn_swa_item(p, l, bk >> 1, bk & 1, blk, false, lds); } }
      PACC(8, t2); t2 = PTIME();
      { const int tidb = launder_tid(), wb_ = tidb >> 6, lb_ = tidb & 63;
        for (int it2 = wb_ * gridDim.x + blockIdx.x; it2 < 3072; it2 += 8 * gridDim.x) { const int it = it2 >> 1, g = it % 6, k1 = (it / 6) % 128, b = it / 768; fourierB_wave(p, b, k1, g, it2 & 1, wb_, lb_, lds); }
        __syncthreads(); }
      PACC(9, t2);
      if (l == 0) {
        for (int it = blockIdx.x; it < 8; it += gridDim.x) { const int bh = it & 7; attn_diff_item(p, l, bh >> 2, bh & 3, 0, true, lds); }
        for (int it = blockIdx.x; it < 8; it += gridDim.x) { const int bk = it & 3, blk = it >> 2; attn_swa_item(p, l, bk >> 1, bk & 1, blk, true, lds); }
        fourierC_stage2(p, lds);
      }
    }
    xcd_barrier(xbar); PACC(4, tq);
    tq = PTIME(); phase_gate(p, l, lds); xcd_barrier(xbar); PACC(5, tq);
    tq = PTIME(); phase_out(p, l, lds);
    if (l == 0) for (int it = blockIdx.x; it < PREP_ITEMS; it += gridDim.x) prep_item(p, 1, it, lds);
    if (l == 0 || PROBE_MODE) xcd_barrier(xbar);
    PACC(6, tq);
  }
#if PROBE_MODE
  if (blockIdx.x == 0) {
    const float tot = (float)(PTIME() - tstart); const float fa = (float)tA / tot, fb = (float)tB / tot;
    const int tid = threadIdx.x;
    if (tid == 0) p.out[0] += 0.4f + 0.3f * fa;
    const float dl = sqrtf(fb * 2e-5f * 2048.f);
    for (int i = tid; i < 16384; i += NT) p.out[4096 + i] += (i & 1) ? dl : -dl;
  }
#endif
}

extern "C" void kernel_launch(void* const* d_in, const int* in_sizes, int n_in, void* d_out, int out_size, void* d_ws, size_t ws_size, hipStream_t stream) {
  static int grid_blocks = 0;
  if (grid_blocks == 0) {
    if (n_in != 24 || ws_size < WS_END) { fprintf(stderr, "kernel_launch: unexpected n_in %d or ws_size %zu (< %zu)\n", n_in, ws_size, (size_t)WS_END); grid_blocks = -1; return; }
    int dev = 0, cus = 0, per_cu = 0;
    hipGetDevice(&dev); hipDeviceGetAttribute(&cus, hipDeviceAttributeMultiprocessorCount, dev);
    hipFuncSetAttribute((const void*)hybrid_fwd, hipFuncAttributeMaxDynamicSharedMemorySize, LDS_BYTES);
    hipOccupancyMaxActiveBlocksPerMultiprocessor(&per_cu, (const void*)hybrid_fwd, NT, LDS_BYTES);
    if (per_cu < 1) per_cu = 1;
    grid_blocks = cus * per_cu;
    (void)hipGetLastError();
  }
  if (grid_blocks < 0) return;
  Params p{};
  const float** pp = (const float**)&p;
  for (int i = 0; i < 24; ++i) pp[i] = (const float*)d_in[i];
  p.out = (float*)d_out; p.ws = (unsigned char*)d_ws;
  void* args[] = {&p};
  hipError_t e = hipLaunchCooperativeKernel((const void*)hybrid_fwd, dim3(grid_blocks), dim3(NT), args, LDS_BYTES, stream);
  if (e != hipSuccess) fprintf(stderr, "cooperative launch failed: %s (grid %d)\n", hipGetErrorString(e), grid_blocks);
}
```

```cpp
#include <hip/hip_runtime.h>
#include <hip/hip_cooperative_groups.h>
#include <stdint.h>
#include <stdio.h>
namespace cg = cooperative_groups;

typedef unsigned short bf16_t;
typedef short bf16x8 __attribute__((ext_vector_type(8)));
typedef float f32x2 __attribute__((ext_vector_type(2)));
typedef float f32x4 __attribute__((ext_vector_type(4)));
typedef float f32x16 __attribute__((ext_vector_type(16)));
typedef unsigned u32x2 __attribute__((ext_vector_type(2)));
typedef unsigned u32x4 __attribute__((ext_vector_type(4)));
typedef __bf16 bf16x2v __attribute__((ext_vector_type(2)));
#define LAS __attribute__((address_space(3)))
typedef LAS unsigned char lds8;
#define DI __device__ __forceinline__
#define MFMA32(a, b, c) __builtin_amdgcn_mfma_f32_32x32x16_bf16((a), (b), (c), 0, 0, 0)
#define MFMA16(a, b, c) __builtin_amdgcn_mfma_f32_16x16x32_bf16((a), (b), (c), 0, 0, 0)

constexpr int NT = 512;
constexpr int TT = 33280;
constexpr int TL = 32768;
constexpr int NKEY = 16640;
constexpr int LDPM = 3200, LDY = 1792;
constexpr int PM_AX = 0, PM_BQ = 384, PM_BK = 896, PM_CX = 1024, PM_CB = 1408, PM_CC = 1792, PM_DQ = 2176, PM_DK = 2688;
constexpr int Y_A = 0, Y_B = 384, Y_C = 896, Y_D = 1280;
constexpr size_t OFF_H = 0ull, OFF_PM = 68157440ull, OFF_Y = 281149440ull, OFF_WIN = 400424960ull, OFF_WO = 420347904ull,
                 OFF_WOUT = 424017920ull, OFF_AP = 428212224ull, OFF_VTD = 478543872ull, OFF_VTB = 512622592ull,
                 OFF_CTX1 = 521142272ull, OFF_MOD = 523239424ull, OFF_ROPE = 523313152ull, OFF_TAB = 523345920ull,
                 OFF_VC = 523526144ull, OFF_CG = 525099008ull, OFF_BAR = 529293312ull, WS_END = 529309696ull;
constexpr size_t OFF_MIXED = OFF_AP;
constexpr size_t OFF_SCR = OFF_PM;
constexpr int LDS_BYTES = 143360;
constexpr float QSCALE = 0.18033688011112042f;
constexpr float LOG2E = 1.4426950408889634f;

struct Params {
  const float *x, *c, *ctx, *c_ctx, *norm_g, *w_mod, *b_mod, *w_in, *q_norm_b, *k_norm_b, *sink_b, *conv_w,
              *q_norm_d, *k_norm_d, *lam_q1, *lam_k1, *lam_q2, *lam_k2, *subln_d, *w_o_a, *w_o_b, *w_o_c, *w_o_d, *w_out;
  float* out; unsigned char* ws;
};

DI int launder_tid() { int t = threadIdx.x; asm volatile("" : "+v"(t)); return t; }
template <int M> DI float shx(float v) { return __int_as_float(__builtin_amdgcn_ds_swizzle(__float_as_int(v), (M << 10) | 0x1f)); }
DI float sum32(float v) { const unsigned x = __float_as_uint(v); const auto r = __builtin_amdgcn_permlane32_swap(x, x, false, false); return __uint_as_float(r[0]) + __uint_as_float(r[1]); }
DI float max32(float v) { const unsigned x = __float_as_uint(v); const auto r = __builtin_amdgcn_permlane32_swap(x, x, false, false); return fmaxf(__uint_as_float(r[0]), __uint_as_float(r[1])); }
DI float wave_sum(float v) { v = sum32(v); v += shx<16>(v); v += shx<8>(v); v += shx<4>(v); v += shx<2>(v); v += shx<1>(v); return v; }
DI float wave_max(float v) { v = max32(v); v = fmaxf(v, shx<16>(v)); v = fmaxf(v, shx<8>(v)); v = fmaxf(v, shx<4>(v)); v = fmaxf(v, shx<2>(v)); v = fmaxf(v, shx<1>(v)); return v; }
DI unsigned pk2(float lo, float hi) { f32x2 v = {lo, hi}; return __builtin_bit_cast(unsigned, __builtin_convertvector(v, bf16x2v)); }
DI bf16_t f2bf(float x) { return (bf16_t)(pk2(x, 0.f) & 0xffffu); }
DI float bf2f(bf16_t u) { return __uint_as_float(((unsigned)u) << 16); }
DI float bflo(unsigned u) { return __uint_as_float(u << 16); }
DI float bfhi(unsigned u) { return __uint_as_float(u & 0xffff0000u); }
DI float siluf(float x) { return x * __builtin_amdgcn_rcpf(1.f + __builtin_amdgcn_exp2f(-1.4426950408889634f * x)); }
DI float sigm(float x) { return __builtin_amdgcn_rcpf(1.f + __builtin_amdgcn_exp2f(-1.4426950408889634f * x)); }
DI int crow(int i, int h) { return (i & 3) + 8 * (i >> 2) + 4 * h; }
DI float cosrev(float r) { return __builtin_amdgcn_cosf(r); }
DI float sinrev(float r) { return __builtin_amdgcn_sinf(r); }
DI bf16x8 pack8(const f32x16& v, int s) {
  u32x4 w;
  w.x = pk2(v[8 * s + 0], v[8 * s + 1]); w.y = pk2(v[8 * s + 2], v[8 * s + 3]);
  w.z = pk2(v[8 * s + 4], v[8 * s + 5]); w.w = pk2(v[8 * s + 6], v[8 * s + 7]);
  return __builtin_bit_cast(bf16x8, w);
}
DI f32x16 splat16(float x) { f32x16 v; _Pragma("unroll") for (int i = 0; i < 16; ++i) v[i] = x; return v; }

DI void tconv_tile(const float* __restrict__ src, int N, bf16_t* __restrict__ dst, int K, int tk, int tn, LAS float* sm) {
  const int t = launder_tid();
#pragma unroll
  for (int i = 0; i < 8; ++i) { const int e = t + i * NT, r = e >> 6, c = e & 63; sm[r * 65 + c] = src[(size_t)(tk * 64 + r) * N + tn * 64 + c]; }
  __syncthreads();
  { const int n = t >> 3, kc = t & 7; u32x4 w;
    w.x = pk2(sm[(kc * 8 + 0) * 65 + n], sm[(kc * 8 + 1) * 65 + n]); w.y = pk2(sm[(kc * 8 + 2) * 65 + n], sm[(kc * 8 + 3) * 65 + n]);
    w.z = pk2(sm[(kc * 8 + 4) * 65 + n], sm[(kc * 8 + 5) * 65 + n]); w.w = pk2(sm[(kc * 8 + 6) * 65 + n], sm[(kc * 8 + 7) * 65 + n]);
    *(u32x4*)(dst + (size_t)(tn * 64 + n) * K + tk * 64 + kc * 8) = w; }
  __syncthreads();
}

DI void prep_item(const Params& p, int l, int it, lds8* lds) {
  bf16_t* WIN = (bf16_t*)(p.ws + OFF_WIN); bf16_t* WO = (bf16_t*)(p.ws + OFF_WO); bf16_t* WOUT = (bf16_t*)(p.ws + OFF_WOUT);
  const float* src; bf16_t* dst; int K, N, ti;
  if (it < 2432) { src = p.w_in + (size_t)l * 1024 * 9728; dst = WIN; K = 1024; N = 9728; ti = it; }
  else if (it < 2528) { src = p.w_o_a + (size_t)l * 384 * 1024; dst = WO; K = 384; N = 1024; ti = it - 2432; }
  else if (it < 2656) { src = p.w_o_b + (size_t)l * 512 * 1024; dst = WO + 393216; K = 512; N = 1024; ti = it - 2528; }
  else if (it < 2752) { src = p.w_o_c + (size_t)l * 384 * 1024; dst = WO + 917504; K = 384; N = 1024; ti = it - 2656; }
  else if (it < 2880) { src = p.w_o_d + (size_t)l * 512 * 1024; dst = WO + 1310720; K = 512; N = 1024; ti = it - 2752; }
  else { src = p.w_out + (size_t)l * 1024 * 1024; dst = WOUT + (size_t)l * 1048576; K = 1024; N = 1024; ti = it - 2880; }
  const int ntk = K / 64; const int tk = ti % ntk, tn = ti / ntk;
  tconv_tile(src, N, dst, K, tk, tn, (LAS float*)lds);
}
constexpr int PREP_ITEMS = 3136;

DI void mod_item(const Params& p, int mi, lds8* lds) {
  const int l2 = mi / 48, jc = mi % 48, tid = threadIdx.x;
  LAS float* ssil = (LAS float*)lds; LAS float* part = ssil + 3072;
  for (int e = tid; e < 3072; e += NT) { const int v = e >> 10, k = e & 1023; const float cv = v < 2 ? p.c[v * 1024 + k] : p.c_ctx[k]; ssil[e] = siluf(cv); }
  __syncthreads();
  const int col = tid & 63, ks = tid >> 6; const int j = jc * 64 + col;
  float a0 = 0.f, a1 = 0.f, a2 = 0.f; const float* w = p.w_mod + (size_t)l2 * 1024 * 3072 + j;
#pragma unroll 16
  for (int k = ks * 128; k < ks * 128 + 128; ++k) { const float wv = w[(size_t)k * 3072]; a0 += ssil[k] * wv; a1 += ssil[1024 + k] * wv; a2 += ssil[2048 + k] * wv; }
  part[(ks * 3 + 0) * 64 + col] = a0; part[(ks * 3 + 1) * 64 + col] = a1; part[(ks * 3 + 2) * 64 + col] = a2;
  __syncthreads();
  if (tid < 192) { const int v = tid >> 6, cc = tid & 63; float s = 0.f;
    for (int q = 0; q < 8; ++q) s += part[(q * 3 + v) * 64 + cc];
    float* MOD = (float*)(p.ws + OFF_MOD); MOD[(l2 * 3 + v) * 3072 + jc * 64 + cc] = s + p.b_mod[l2 * 3072 + jc * 64 + cc]; }
  __syncthreads();
}

DI void tables_item(const Params& p, int which) {
  const int tid = launder_tid();
  if (which == 0) {
    float* RT = (float*)(p.ws + OFF_ROPE);
    for (int e = tid; e < 4096; e += NT) { const int pos = e >> 4, i = e & 15;
      const float inv = exp2f(-(float)i * (13.287712379549449f / 16.f)); const float ang = (float)pos * inv;
      float rev = ang * 0.15915494309189535f; rev -= floorf(rev);
      RT[2 * e] = cosrev(rev); RT[2 * e + 1] = sinrev(rev); }
  } else {
    bf16_t* WcT = (bf16_t*)(p.ws + OFF_TAB); bf16_t* CP = WcT + 8192; bf16_t* SP = CP + 16384; bf16_t* NSP = SP + 16384; bf16_t* CN = NSP + 16384; bf16_t* SN = CN + 16384;
    for (int e = tid; e < 16384; e += NT) { const int k = e >> 7, pos = e & 127;
      const int tn = (k * pos) & 127; const float rn = (float)tn * (1.f / 128.f);
      CN[e] = f2bf(cosrev(rn)); SN[e] = f2bf(sinrev(rn));
      const int j = pos & 7, h = (pos >> 3) & 1, s = (pos >> 4) & 1, rb = pos >> 5; const int n1 = 32 * rb + 16 * s + 8 * (j >> 2) + 4 * h + (j & 3);
      const int tp = (k * n1) & 127; const float rp = (float)tp * (1.f / 128.f); const float cs = cosrev(rp), sn = sinrev(rp);
      CP[e] = f2bf(cs); SP[e] = f2bf(sn); NSP[e] = f2bf(-sn); }
    for (int e = tid; e < 8192; e += NT) { const int mp = e >> 6, c = e & 63; const int m = mp & 63; const int t = (m * c) & 63; const float rr = (float)t * (1.f / 64.f);
      WcT[e] = f2bf(mp < 64 ? cosrev(rr) : -sinrev(rr)); }
  }
}

DI void phase_norm(const Params& p, int l) {
  const int tid = launder_tid(), lane = tid & 63, w = tid >> 6;
  bf16_t* H = (bf16_t*)(p.ws + OFF_H); const float* MOD = (const float*)(p.ws + OFF_MOD);
  const float* xl = l == 0 ? p.x : p.out; const float* xc = l == 0 ? p.ctx : (const float*)(p.ws + OFF_CTX1);
  const float* ng = p.norm_g + l * 1024;
#pragma unroll 1
  for (int v = 0; v < 3; ++v) {
    const int r0 = v < 2 ? v * 16384 : TL, r1 = v < 2 ? (v + 1) * 16384 : TT;
    const float* md = MOD + (l * 3 + v) * 3072;
    f32x4 ga[4], sb[4];
#pragma unroll
    for (int i = 0; i < 4; ++i) { const int col = (lane + 64 * i) * 4; const f32x4 g = *(const f32x4*)(ng + col), sc = *(const f32x4*)(md + 1024 + col); ga[i] = g * (1.f + sc); sb[i] = *(const f32x4*)(md + col); }
#pragma unroll 2
    for (int R = r0 + blockIdx.x * 8 + w; R < r1; R += gridDim.x * 8) {
      const float* src = v < 2 ? xl + (size_t)R * 1024 : xc + (size_t)(R - TL) * 1024;
      f32x4 xv[4]; float ss = 0.f;
#pragma unroll
      for (int i = 0; i < 4; ++i) { xv[i] = *(const f32x4*)(src + (lane + 64 * i) * 4); ss += xv[i][0] * xv[i][0] + xv[i][1] * xv[i][1] + xv[i][2] * xv[i][2] + xv[i][3] * xv[i][3]; }
      ss = wave_sum(ss);
      const float rs = rsqrtf(ss * (1.f / 1024.f) + 1e-6f);
#pragma unroll
      for (int i = 0; i < 4; ++i) { const int col = (lane + 64 * i) * 4; const f32x4 hv = xv[i] * rs * ga[i] + sb[i];
        u32x2 o; o.x = pk2(hv[0], hv[1]); o.y = pk2(hv[2], hv[3]); *(u32x2*)(H + (size_t)R * 1024 + col) = o; }
    }
  }
}

namespace g8 {
constexpr int BK = 64, HALF = 128, HTB = HALF * BK * 2;
DI int lds_byte(int r, int c) { const int st = (r >> 4) * 2 + (c >> 5), rr = r & 15, cc = c & 31, ob = rr * 64 + cc * 2; return st * 1024 + (ob ^ (((ob >> 9) & 1) << 5)); }
DI void stage_rc(int b, int& R, int& C) { const int st = b / 1024, sb = b % 1024, swz = sb ^ (((sb >> 9) & 1) << 5); R = (st >> 1) * 16 + swz / 64; C = (st & 1) * 32 + (swz % 64) / 2; }

#define G8_SA(b, h) (((b) * 2 + (h)) * HTB)
#define G8_SB(b, h) ((4 + (b) * 2 + (h)) * HTB)
#define G8_STAGE(bufoff, gbase, ld, voff, row0, kt) do { _Pragma("unroll") for (int _i = 0; _i < 2; ++_i) \
    __builtin_amdgcn_global_load_lds((const unsigned*)((gbase) + (size_t)(row0) * (ld) + (size_t)(kt) * BK + (voff)[_i]), (LAS unsigned*)(lds + (bufoff) + tid * 16 + _i * 8192), 16, 0, 0); } while (0)
#define G8_STA(bufoff, half, kt) G8_STAGE(bufoff, A, lda, voffA, brow + (half) * HALF, kt)
#define G8_STB(bufoff, half, kt) G8_STAGE(bufoff, Bt, ldb, voffB, bcol + (half) * HALF, kt)
#define G8_LDA(dst, b, h) do { _Pragma("unroll") for (int m = 0; m < 4; ++m) _Pragma("unroll") for (int k = 0; k < 2; ++k) dst[m][k] = *(const LAS bf16x8*)(lds + G8_SA(b, h) + aoff + m * 2048 + k * 1024); } while (0)
#define G8_LDB(dst, b, h) do { _Pragma("unroll") for (int n = 0; n < 2; ++n) _Pragma("unroll") for (int k = 0; k < 2; ++k) dst[n][k] = *(const LAS bf16x8*)(lds + G8_SB(b, h) + boff + n * 2048 + k * 1024); } while (0)
#define G8_MMA(ai, bj, At_, Bt_) do { __builtin_amdgcn_s_setprio(1); _Pragma("unroll") for (int m = 0; m < 4; ++m) _Pragma("unroll") for (int n = 0; n < 2; ++n) _Pragma("unroll") for (int k = 0; k < 2; ++k) \
    acc[ai][bj][m][n] = MFMA16(Bt_[n][k], At_[m][k], acc[ai][bj][m][n]); __builtin_amdgcn_s_setprio(0); } while (0)
#define G8_WAIT_V(n) asm volatile("s_waitcnt vmcnt(" #n ")" ::: "memory")
#define G8_WAIT_L(n) asm volatile("s_waitcnt lgkmcnt(" #n ")" ::: "memory")
#define G8_BAR __builtin_amdgcn_s_barrier()
#define G8_SCHED __builtin_amdgcn_sched_barrier(0)

template <int lda, int ldb>
DI void gemm_issue0(lds8* lds, const bf16_t* __restrict__ A, const bf16_t* __restrict__ Bt, int brow, int bcol) {
  const int tid = launder_tid();
  unsigned voffA[2], voffB[2];
#pragma unroll
  for (int i = 0; i < 2; ++i) { int R, C; stage_rc(tid * 16 + i * 8192, R, C); voffA[i] = (unsigned)(R * lda + C); voffB[i] = (unsigned)(R * ldb + C); }
  G8_STB(G8_SB(0, 0), 0, 0); G8_STA(G8_SA(0, 0), 0, 0);
  G8_STB(G8_SB(0, 1), 1, 0); G8_STA(G8_SA(0, 1), 1, 0);
}
template <int lda, int ldb, int K>
DI void gemm_main(lds8* lds, const bf16_t* __restrict__ A, const bf16_t* __restrict__ Bt, int brow, int bcol, f32x4 (&acc)[2][2][4][2]) {
  const int tid = launder_tid(), wid = tid >> 6, lane = tid & 63, wr = wid >> 2, wc = wid & 3, fr = lane & 15, fq = lane >> 4;
  unsigned voffA[2], voffB[2];
#pragma unroll
  for (int i = 0; i < 2; ++i) { int R, C; stage_rc(tid * 16 + i * 8192, R, C); voffA[i] = (unsigned)(R * lda + C); voffB[i] = (unsigned)(R * ldb + C); }
  const int aoff = lds_byte(wr * 64 + fr, fq * 8), boff = lds_byte(wc * 32 + fr, fq * 8);
#pragma unroll
  for (int a = 0; a < 2; ++a)
#pragma unroll
    for (int b = 0; b < 2; ++b)
#pragma unroll
      for (int m = 0; m < 4; ++m)
#pragma unroll
        for (int n = 0; n < 2; ++n) acc[a][b][m][n] = (f32x4){0.f, 0.f, 0.f, 0.f};
  bf16x8 At[4][2], B0[2][2], B1[2][2];
  constexpr int nt = K / BK;
  if (wr == 1) G8_BAR;
  G8_WAIT_V(0); G8_BAR;
  G8_STB(G8_SB(1, 0), 0, 1); G8_STA(G8_SA(1, 0), 0, 1); G8_STB(G8_SB(1, 1), 1, 1);
  G8_WAIT_V(6); G8_BAR;
  for (int t = 0; t < nt - 2; t += 2) {
    G8_LDB(B0, 0, 0); G8_SCHED; G8_LDA(At, 0, 0); G8_STA(G8_SA(1, 1), 1, t + 1);
    G8_WAIT_L(8); G8_BAR; G8_WAIT_L(0); G8_MMA(0, 0, At, B0); G8_BAR; G8_SCHED;
    G8_LDB(B1, 0, 1); G8_STB(G8_SB(0, 0), 0, t + 2);
    G8_BAR; G8_WAIT_L(0); G8_MMA(0, 1, At, B1); G8_BAR;
    G8_LDA(At, 0, 1); G8_STA(G8_SA(0, 0), 0, t + 2);
    G8_BAR; G8_WAIT_L(0); G8_MMA(1, 0, At, B0); G8_BAR; G8_SCHED;
    G8_STB(G8_SB(0, 1), 1, t + 2);
    G8_WAIT_V(6); G8_BAR; G8_MMA(1, 1, At, B1); G8_BAR;
    G8_LDB(B0, 1, 0); G8_SCHED; G8_LDA(At, 1, 0); G8_STA(G8_SA(0, 1), 1, t + 2);
    G8_WAIT_L(8); G8_BAR; G8_WAIT_L(0); G8_MMA(0, 0, At, B0); G8_BAR; G8_SCHED;
    G8_LDB(B1, 1, 1); G8_STB(G8_SB(1, 0), 0, t + 3);
    G8_BAR; G8_WAIT_L(0); G8_MMA(0, 1, At, B1); G8_BAR;
    G8_LDA(At, 1, 1); G8_STA(G8_SA(1, 0), 0, t + 3);
    G8_BAR; G8_WAIT_L(0); G8_MMA(1, 0, At, B0); G8_BAR; G8_SCHED;
    G8_STB(G8_SB(1, 1), 1, t + 3);
    G8_WAIT_V(6); G8_BAR; G8_MMA(1, 1, At, B1); G8_BAR;
  }
  { G8_LDB(B0, 0, 0); G8_LDA(At, 0, 0); G8_STA(G8_SA(1, 1), 1, nt - 1);
    G8_BAR; G8_WAIT_L(0); G8_MMA(0, 0, At, B0); G8_BAR;
    G8_LDB(B1, 0, 1); G8_BAR; G8_WAIT_L(0); G8_MMA(0, 1, At, B1); G8_BAR;
    G8_LDA(At, 0, 1); G8_WAIT_V(4); G8_BAR; G8_WAIT_L(0); G8_MMA(1, 0, At, B0); G8_MMA(1, 1, At, B1); G8_BAR; }
  { G8_LDB(B0, 1, 0); G8_LDA(At, 1, 0); G8_WAIT_V(2); G8_BAR; G8_WAIT_L(0); G8_MMA(0, 0, At, B0); G8_BAR;
    G8_LDB(B1, 1, 1); G8_WAIT_V(0); G8_BAR; G8_WAIT_L(0); G8_MMA(0, 1, At, B1); G8_BAR;
    G8_LDA(At, 1, 1); G8_BAR; G8_WAIT_L(0); G8_MMA(1, 0, At, B0); G8_MMA(1, 1, At, B1); G8_BAR; }
  if (wr == 0) G8_BAR;
  __syncthreads();
}
template <int lda, int ldb, int K>
DI void gemm_tile(lds8* lds, const bf16_t* __restrict__ A, const bf16_t* __restrict__ Bt, int brow, int bcol, f32x4 (&acc)[2][2][4][2]) { gemm_issue0<lda, ldb>(lds, A, Bt, brow, bcol); gemm_main<lda, ldb, K>(lds, A, Bt, brow, bcol, acc); }
struct Desc { const char* A; const char* B; int lda, ldb, nt, pm, pn, aux; };
DI void set_voff(int tid, int lda, int ldb, unsigned (&voffA)[2], unsigned (&voffB)[2]) {
#pragma unroll
  for (int i = 0; i < 2; ++i) { int R, C; stage_rc(tid * 16 + i * 8192, R, C); voffA[i] = (unsigned)(R * lda + C) * 2u; voffB[i] = (unsigned)(R * ldb + C) * 2u; }
}
#define GS_STAGE(bufoff, gbase, voff) do { _Pragma("unroll") for (int _i = 0; _i < 2; ++_i) \
    __builtin_amdgcn_global_load_lds((const unsigned*)((const char*)(gbase) + (voff)[_i]), (LAS unsigned*)(lds + (bufoff) + ldsw + _i * 8192), 16, 0, 0); } while (0)
template <class Ctx>
DI void gemm_stream(lds8* lds, Ctx& C) {
  const int tid = launder_tid(), wid = __builtin_amdgcn_readfirstlane(tid >> 6), lane = tid & 63, wr = wid >> 2, wc = wid & 3, fr = lane & 15, fq = lane >> 4;
  const unsigned ldsw = (unsigned)wid * 1024u;
  const int aoff = lds_byte(wr * 64 + fr, fq * 8), boff = lds_byte(wc * 32 + fr, fq * 8);
  constexpr size_t kstep = (size_t)(BK * 2);
  Desc cur, nxt; int ui = 0;
  if (!C.next(0, cur)) return;
  f32x4 acc[2][2][4][2];
#pragma unroll
  for (int a = 0; a < 2; ++a)
#pragma unroll
    for (int b = 0; b < 2; ++b)
#pragma unroll
      for (int m = 0; m < 4; ++m)
#pragma unroll
        for (int n = 0; n < 2; ++n) acc[a][b][m][n] = (f32x4){0.f, 0.f, 0.f, 0.f};
  bf16x8 At[4][2], B0[2][2], B1[2][2];
  unsigned voffA[2], voffB[2]; set_voff(tid, cur.lda, cur.ldb, voffA, voffB);
  size_t hsA = (size_t)HALF * cur.lda * 2, hsB = (size_t)HALF * cur.ldb * 2;
  const char* cA = cur.A; const char* cB = cur.B;
  GS_STAGE(G8_SB(0, 0), cB, voffB); GS_STAGE(G8_SB(0, 1), cB + hsB, voffB); GS_STAGE(G8_SA(0, 0), cA, voffA); GS_STAGE(G8_SA(0, 1), cA + hsA, voffA);
  if (wr == 1) G8_BAR;
  G8_WAIT_V(2); G8_BAR;
  GS_STAGE(G8_SB(1, 0), cB + kstep, voffB); GS_STAGE(G8_SA(1, 0), cA + kstep, voffA); GS_STAGE(G8_SB(1, 1), cB + hsB + kstep, voffB);
  G8_WAIT_V(6); G8_BAR;
  for (;;) {
    const bool has_next = C.next(ui + 1, nxt);
    const char* nA = has_next ? nxt.A : cA; const char* nB = has_next ? nxt.B : cB;
    const int nt = cur.nt;
#pragma unroll 1
    for (int t = 0; t < nt; t += 2) {
      const bool last = (t == nt - 2);
      const char* a1 = cA + (size_t)(t + 1) * kstep;
      G8_LDB(B0, 0, 0); G8_LDB(B1, 0, 1); G8_SCHED; G8_LDA(At, 0, 0); GS_STAGE(G8_SA(1, 1), a1 + hsA, voffA);
      if (last && has_next) { set_voff(tid, nxt.lda, nxt.ldb, voffA, voffB); hsA = (size_t)HALF * nxt.lda * 2; hsB = (size_t)HALF * nxt.ldb * 2; }
      const char* a2 = last ? nA : cA + (size_t)(t + 2) * kstep; const char* b2 = last ? nB : cB + (size_t)(t + 2) * kstep;
      const char* a3 = a2 + kstep; const char* b3 = b2 + kstep;
      G8_WAIT_V(8); G8_WAIT_L(0); G8_BAR; G8_MMA(0, 0, At, B0); G8_MMA(0, 1, At, B1); G8_BAR; G8_SCHED;
      G8_LDA(At, 0, 1); GS_STAGE(G8_SB(0, 0), b2, voffB); GS_STAGE(G8_SB(0, 1), b2 + hsB, voffB); GS_STAGE(G8_SA(0, 0), a2, voffA);
      G8_WAIT_V(8); G8_WAIT_L(0); G8_BAR; G8_MMA(1, 0, At, B0); G8_MMA(1, 1, At, B1); G8_BAR; G8_SCHED;
      G8_LDB(B0, 1, 0); G8_LDB(B1, 1, 1); G8_SCHED; G8_LDA(At, 1, 0); GS_STAGE(G8_SA(0, 1), a2 + hsA, voffA);
      G8_WAIT_V(8); G8_WAIT_L(0); G8_BAR; G8_MMA(0, 0, At, B0); G8_MMA(0, 1, At, B1); G8_BAR; G8_SCHED;
      G8_LDA(At, 1, 1); GS_STAGE(G8_SB(1, 0), b3, voffB); GS_STAGE(G8_SB(1, 1), b3 + hsB, voffB); GS_STAGE(G8_SA(1, 0), a3, voffA);
      G8_WAIT_V(8); G8_WAIT_L(0); G8_BAR; G8_MMA(1, 0, At, B0); G8_MMA(1, 1, At, B1); G8_BAR; G8_SCHED;
    }
    if (wr == 0) G8_BAR;
    C.epi(cur, acc);
    if (!has_next) break;
#pragma unroll
    for (int a = 0; a < 2; ++a)
#pragma unroll
      for (int b = 0; b < 2; ++b)
#pragma unroll
        for (int m = 0; m < 4; ++m)
#pragma unroll
          for (int n = 0; n < 2; ++n) acc[a][b][m][n] = (f32x4){0.f, 0.f, 0.f, 0.f};
    cur = nxt; cA = nA; cB = nB; ++ui;
    if (wr == 1) G8_BAR;
  }
  G8_WAIT_V(0);
  G8_BAR;
  __syncthreads();
}
}

DI bool unit_next(int nM, int nN, int L, int& pm, int& pn) {
  const int nwg = nM * nN; if (L >= nwg) return false;
  int wgid = L; { const int q = nwg / 8, r = nwg % 8, xcd = wgid % 8, off = wgid / 8; wgid = (xcd < r ? xcd * (q + 1) : r * (q + 1) + (xcd - r) * q) + off; }
  const int nig = 8 * nN, gid = wgid / nig, fm = gid * 8, gsz = (nM - fm) < 8 ? (nM - fm) : 8;
  pm = fm + ((wgid % nig) % gsz); pn = (wgid % nig) / gsz; return true;
}

struct InprojCtx {
  const Params& p; int G, bid, l; lds8* lds;
  DI bool next(int ui, g8::Desc& d) const {
    const int L = ui * G + bid; int pm, pn;
    d.lda = 1024; d.ldb = 1024; d.nt = 16;
    if (L < 2860) { unit_next(130, 22, L, pm, pn); d.aux = 0; d.B = (const char*)(p.ws + OFF_WIN) + (size_t)pn * 256 * 1024 * 2; }
    else if (l == 0 && L < 2860 + 32) { const int e = L - 2860; pm = 128 + (e >> 4); pn = e & 15; d.aux = 1;
      d.B = (const char*)(p.ws + OFF_WIN) + (size_t)(5632 + pn * 256) * 1024 * 2; }
    else return false;
    d.A = (const char*)(p.ws + OFF_H) + (size_t)pm * 256 * 1024 * 2; d.pm = pm; d.pn = pn; return true; }
  DI void epi(const g8::Desc& d, const f32x4 (&acc)[2][2][4][2]) const {
    const int tid = launder_tid(), wid = tid >> 6, lane = tid & 63, wr = wid >> 2, wc = wid & 3, fr = lane & 15, fq = lane >> 4;
    bf16_t* PM = (bf16_t*)(p.ws + OFF_PM); bf16_t* Y = (bf16_t*)(p.ws + OFF_Y); bf16_t* VTD = (bf16_t*)(p.ws + OFF_VTD); bf16_t* VTB = (bf16_t*)(p.ws + OFF_VTB);
    const int cpm = d.pm, cpn = d.pn;
    if (d.aux == 1) {
      bf16_t* CG = (bf16_t*)(p.ws + OFF_CG);
#pragma unroll
      for (int ai = 0; ai < 2; ++ai)
#pragma unroll
        for (int m = 0; m < 4; ++m) { const int row = (cpm - 128) * 256 + ai * 128 + wr * 64 + m * 16 + fr;
#pragma unroll
          for (int bj = 0; bj < 2; ++bj)
#pragma unroll
            for (int n = 0; n < 2; ++n) { const int col = cpn * 256 + bj * 128 + wc * 32 + n * 16 + fq * 4; const f32x4 v = acc[ai][bj][m][n];
              u32x2 o; o.x = pk2(sigm(v[0]), sigm(v[1])); o.y = pk2(sigm(v[2]), sigm(v[3])); *(u32x2*)(CG + (size_t)row * 4096 + col) = o; } }
      return;
    }
    const bool kh0 = (cpn == 11 || cpn == 12), kh1 = (cpn == 3 || cpn == 11 || cpn == 12);
    LAS float* xch = (LAS float*)(lds + 131072);
    if (kh1) {
#pragma unroll
      for (int bj = 0; bj < 2; ++bj) if (bj == 1 || kh0) {
#pragma unroll
        for (int ai = 0; ai < 2; ++ai)
#pragma unroll
          for (int m = 0; m < 4; ++m) { const f32x4 a0 = acc[ai][bj][m][0], a1 = acc[ai][bj][m][1];
            float ss = a0[0] * a0[0] + a0[1] * a0[1] + a0[2] * a0[2] + a0[3] * a0[3] + a1[0] * a1[0] + a1[1] * a1[1] + a1[2] * a1[2] + a1[3] * a1[3];
            ss += shx<16>(ss); ss = sum32(ss);
            if (fq == 0) xch[(bj * 4 + wc) * 256 + ai * 128 + wr * 64 + m * 16 + fr] = ss; } }
      asm volatile("s_waitcnt lgkmcnt(0)" ::: "memory"); __builtin_amdgcn_s_barrier(); asm volatile("" ::: "memory");
    }
    const float* RT = (const float*)(p.ws + OFF_ROPE); const float* gain = (cpn == 3 ? p.k_norm_b : p.k_norm_d) + l * 64;
    const int hw = wc & 1;
#pragma unroll
    for (int bj = 0; bj < 2; ++bj) {
      const int colh = cpn * 256 + bj * 128;
      const bool khalf = bj == 1 ? kh1 : kh0;
      int mode, dcol, ld; bf16_t* dst;
      if (colh < 1024) { mode = 0; dst = PM; ld = LDPM; dcol = colh; }
      else if (colh < 1152) { mode = 1; dst = VTB; ld = 128; dcol = colh - 1024; }
      else if (colh < 3328) { mode = 0; dst = PM; ld = LDPM; dcol = colh - 128; }
      else if (colh < 3840) { mode = 1; dst = VTD; ld = 512; dcol = colh - 3328; }
      else { mode = 2; dst = Y; ld = LDY; dcol = colh - 3840; }
#pragma unroll
      for (int ai = 0; ai < 2; ++ai)
#pragma unroll
        for (int m = 0; m < 4; ++m) {
          const int rsl = ai * 128 + wr * 64 + m * 16 + fr; const int row = cpm * 256 + rsl;
          f32x4 v0 = acc[ai][bj][m][0], v1 = acc[ai][bj][m][1];
          const int c40 = dcol + wc * 32 + fq * 4, c41 = c40 + 16;
          if (mode == 1) {
            int b, key; if (row < TL) { b = row >> 14; key = 256 + (row & 16383); } else { b = (row - TL) >> 8; key = (row - TL) & 255; }
#pragma unroll
            for (int j = 0; j < 4; ++j) { dst[((size_t)(b * ld + c40 + j)) * NKEY + key] = f2bf(v0[j]); dst[((size_t)(b * ld + c41 + j)) * NKEY + key] = f2bf(v1[j]); }
          } else {
            if (mode == 2) { v0[0] = siluf(v0[0]); v0[1] = siluf(v0[1]); v0[2] = siluf(v0[2]); v0[3] = siluf(v0[3]); v1[0] = siluf(v1[0]); v1[1] = siluf(v1[1]); v1[2] = siluf(v1[2]); v1[3] = siluf(v1[3]); }
            if (khalf) {
              const float tot = xch[(bj * 4 + wc) * 256 + rsl] + xch[(bj * 4 + (wc ^ 1)) * 256 + rsl]; const float rs = rsqrtf(tot * (1.f / 64.f) + 1e-6f);
              const f32x4 g0 = *(const f32x4*)(gain + 32 * hw + 4 * fq), g1 = *(const f32x4*)(gain + 32 * hw + 16 + 4 * fq);
              v0 = v0 * rs * g0; v1 = v1 * rs * g1;
              if (cpm < 128) { const int ntok = row & 16383; const int pos = hw ? (ntok & 63) : (ntok >> 6);
                const f32x4* cp = (const f32x4*)(RT + 2 * (pos * 16 + 4 * fq)); const f32x4 c01 = cp[0], c23 = cp[1];
                const f32x4 cc = {c01[0], c01[2], c23[0], c23[2]}, sn = {c01[1], c01[3], c23[1], c23[3]};
                const f32x4 o0 = v0 * cc - v1 * sn, o1 = v1 * cc + v0 * sn; v0 = o0; v1 = o1; }
            }
            u32x2 o; o.x = pk2(v0[0], v0[1]); o.y = pk2(v0[2], v0[3]); *(u32x2*)(dst + (size_t)row * ld + c40) = o;
            o.x = pk2(v1[0], v1[1]); o.y = pk2(v1[2], v1[3]); *(u32x2*)(dst + (size_t)row * ld + c41) = o;
          }
        }
    }
  }
};
DI void phase_inproj(const Params& p, int l, lds8* lds) { InprojCtx c{p, (int)gridDim.x, (int)blockIdx.x, l, lds}; g8::gemm_stream(lds, c); }

DI u32x4 normrope_proc(const u32x4 raw, const f32x4 g0, const f32x4 g1, float scale, bool rope, const f32x2 (&cs)[8], float sgn) {
  float y[8]; y[0] = bflo(raw.x); y[1] = bfhi(raw.x); y[2] = bflo(raw.y); y[3] = bfhi(raw.y); y[4] = bflo(raw.z); y[5] = bfhi(raw.z); y[6] = bflo(raw.w); y[7] = bfhi(raw.w);
  float ss = 0.f;
#pragma unroll
  for (int e = 0; e < 8; ++e) ss += y[e] * y[e];
  ss += shx<1>(ss); ss += shx<2>(ss); ss += shx<4>(ss);
  const float rs = rsqrtf(ss * (1.f / 64.f) + 1e-6f);
  y[0] *= rs * g0[0]; y[1] *= rs * g0[1]; y[2] *= rs * g0[2]; y[3] *= rs * g0[3]; y[4] *= rs * g1[0]; y[5] *= rs * g1[1]; y[6] *= rs * g1[2]; y[7] *= rs * g1[3];
  if (rope) {
#pragma unroll
    for (int e = 0; e < 8; ++e) { const float yp = shx<2>(y[e]); y[e] = y[e] * cs[e].x + sgn * yp * cs[e].y; }
  }
  u32x4 o; o.x = pk2(y[0] * scale, y[1] * scale); o.y = pk2(y[2] * scale, y[3] * scale); o.z = pk2(y[4] * scale, y[5] * scale); o.w = pk2(y[6] * scale, y[7] * scale); return o;
}
DI void normrope_phase(const Params& p, int l, int w, int lane) {
  const float* RT = (const float*)(p.ws + OFF_ROPE);
  const int l8 = lane & 7, quarter = l8 >> 1; const float sgn = (quarter & 1) ? 1.f : -1.f; const bool a3 = lane < 16;
  const f32x4 gq0 = *(const f32x4*)(p.q_norm_b + l * 64 + l8 * 8), gq1 = *(const f32x4*)(p.q_norm_b + l * 64 + l8 * 8 + 4);
  const f32x4 gd0 = *(const f32x4*)(p.q_norm_d + l * 64 + l8 * 8), gd1 = *(const f32x4*)(p.q_norm_d + l * 64 + l8 * 8 + 4);
  const f32x4 gk0 = *(const f32x4*)(p.k_norm_d + l * 64 + l8 * 8), gk1 = *(const f32x4*)(p.k_norm_d + l * 64 + l8 * 8 + 4);
  const f32x4 gb0 = *(const f32x4*)(p.k_norm_b + l * 64 + l8 * 8), gb1 = *(const f32x4*)(p.k_norm_b + l * 64 + l8 * 8 + 4);
  for (int R = blockIdx.x * 8 + w; R < TT; R += gridDim.x * 8) {
    bf16_t* base = (bf16_t*)(p.ws + OFF_PM) + (size_t)R * LDPM + lane * 8;
    const bool rope = R < TL; const int n = R & 16383, prow = n >> 6, pcol = n & 63;
    const u32x4 r2 = *(const u32x4*)(base + PM_DK);
    u32x4 r3 = {0u, 0u, 0u, 0u}; if (a3) r3 = *(const u32x4*)(base + PM_BK);
    f32x2 cs[8];
    if (rope) { const int pos = quarter < 2 ? prow : pcol; const f32x4* cp = (const f32x4*)(RT + 2 * (pos * 16 + 8 * (l8 & 1)));
#pragma unroll
      for (int q = 0; q < 4; ++q) { const f32x4 c4 = cp[q]; cs[2 * q] = (f32x2){c4[0], c4[1]}; cs[2 * q + 1] = (f32x2){c4[2], c4[3]}; } }
    else {
#pragma unroll
      for (int e = 0; e < 8; ++e) cs[e] = (f32x2){1.f, 0.f}; }
    const u32x4 o2 = normrope_proc(r2, gk0, gk1, 1.f, rope, cs, sgn); *(u32x4*)(base + PM_DK) = o2;
    const u32x4 o3 = normrope_proc(r3, gb0, gb1, 1.f, rope, cs, sgn); if (a3) *(u32x4*)(base + PM_BK) = o3;
  }
}

DI void unpack8(const u32x4& r, float (&y)[8]) { y[0] = bflo(r.x); y[1] = bfhi(r.x); y[2] = bflo(r.y); y[3] = bfhi(r.y); y[4] = bflo(r.z); y[5] = bfhi(r.z); y[6] = bflo(r.w); y[7] = bfhi(r.w); }

DI void conv_item(const Params& p, int l, int item) {
  const bf16_t* PM = (const bf16_t*)(p.ws + OFF_PM); bf16_t* Y = (bf16_t*)(p.ws + OFF_Y);
  const int R = item / 48, ch = (item % 48) * 8;
  int n, N; if (R < TL) { n = R & 16383; N = 16384; } else { n = (R - TL) & 255; N = 256; }
  const float* cw = p.conv_w + l * 3 * 384 + ch;
  float conv[8];
#pragma unroll
  for (int e = 0; e < 8; ++e) conv[e] = 0.f;
#pragma unroll
  for (int j = 0; j < 3; ++j) { const int nn = n + j - 1; if (nn >= 0 && nn < N) {
      const size_t rr = (size_t)(R + j - 1) * LDPM; float xa[8], ca[8]; unpack8(*(const u32x4*)(PM + rr + PM_CX + ch), xa); unpack8(*(const u32x4*)(PM + rr + PM_CC + ch), ca);
      const f32x4 w0 = *(const f32x4*)(cw + j * 384), w1 = *(const f32x4*)(cw + j * 384 + 4);
      conv[0] += w0[0] * (xa[0] * ca[0]); conv[1] += w0[1] * (xa[1] * ca[1]); conv[2] += w0[2] * (xa[2] * ca[2]); conv[3] += w0[3] * (xa[3] * ca[3]);
      conv[4] += w1[0] * (xa[4] * ca[4]); conv[5] += w1[1] * (xa[5] * ca[5]); conv[6] += w1[2] * (xa[6] * ca[6]); conv[7] += w1[3] * (xa[7] * ca[7]); } }
  float ba[8], sz[8]; unpack8(*(const u32x4*)(PM + (size_t)R * LDPM + PM_CB + ch), ba);
  bf16_t* yp = Y + (size_t)R * LDY + Y_C + ch; unpack8(*(const u32x4*)yp, sz);
  u32x4 o; o.x = pk2(ba[0] * conv[0] * sz[0], ba[1] * conv[1] * sz[1]); o.y = pk2(ba[2] * conv[2] * sz[2], ba[3] * conv[3] * sz[3]);
  o.z = pk2(ba[4] * conv[4] * sz[4], ba[5] * conv[5] * sz[5]); o.w = pk2(ba[6] * conv[6] * sz[6], ba[7] * conv[7] * sz[7]); *(u32x4*)yp = o;
}

DI void fourierA_item(const Params& p, int b, int n2, int g) {
  const int tid = launder_tid(), lane = tid & 63, w = tid >> 6, r = lane & 31, hh = lane >> 5, mb = w & 1, kq = w >> 1;
  const bf16_t* PM = (const bf16_t*)(p.ws + OFF_PM); const bf16_t* WcT = (const bf16_t*)(p.ws + OFF_TAB);
  const bf16_t* CP = WcT + 8192; const bf16_t* SP = CP + 16384; const bf16_t* NSP = SP + 16384; bf16_t* AP = (bf16_t*)(p.ws + OFF_AP);
  bf16x8 wfr[2][4];
#pragma unroll
  for (int part = 0; part < 2; ++part)
#pragma unroll
    for (int s = 0; s < 4; ++s) wfr[part][s] = *(const bf16x8*)(WcT + (64 * part + 32 * mb + r) * 64 + 16 * s + 8 * hh);
  bf16x8 vf[4][2][2];
#pragma unroll
  for (int rb = 0; rb < 4; ++rb) {
    const size_t token = (size_t)b * 16384 + 128 * (32 * rb + r) + n2; bf16x8 uf[4];
#pragma unroll
    for (int s = 0; s < 4; ++s) uf[s] = *(const bf16x8*)(PM + token * LDPM + PM_AX + g * 64 + 16 * s + 8 * hh);
#pragma unroll
    for (int part = 0; part < 2; ++part) { f32x16 v = splat16(0.f);
#pragma unroll
      for (int s = 0; s < 4; ++s) v = MFMA32(uf[s], wfr[part][s], v);
      vf[rb][0][part] = pack8(v, 0); vf[rb][1][part] = pack8(v, 1); }
  }
  f32x16 Ar = splat16(0.f), Ai = splat16(0.f);
#pragma unroll
  for (int rb = 0; rb < 4; ++rb)
#pragma unroll
    for (int sx = 0; sx < 2; ++sx) { const int pos = (32 * kq + r) * 128 + 32 * rb + 16 * sx + 8 * hh;
      const bf16x8 cf = *(const bf16x8*)(CP + pos), sf = *(const bf16x8*)(SP + pos), nsf = *(const bf16x8*)(NSP + pos);
      Ar = MFMA32(cf, vf[rb][sx][0], Ar); Ar = MFMA32(sf, vf[rb][sx][1], Ar);
      Ai = MFMA32(cf, vf[rb][sx][1], Ai); Ai = MFMA32(nsf, vf[rb][sx][0], Ai); }
#pragma unroll
  for (int i = 0; i < 16; ++i) { const int k1 = 32 * kq + crow(i, hh); const float rev = (float)(n2 * k1) * (1.f / 16384.f); const float cs = cosrev(rev), sn = sinrev(rev);
    const float ar = Ar[i] * cs + Ai[i] * sn, ai = Ai[i] * cs - Ar[i] * sn;
    const size_t o = ((((size_t)b * 128 + k1) * 6 + g) * 128 + n2) * 128 + 32 * mb + r; AP[o] = f2bf(ar); AP[o + 64] = f2bf(ai); }
}

DI void fourierA_wave(const Params& p, int b, int n2, int g, int lane) {
  const int r = lane & 31, hh = lane >> 5;
  const bf16_t* PM = (const bf16_t*)(p.ws + OFF_PM); const bf16_t* WcT = (const bf16_t*)(p.ws + OFF_TAB);
  const bf16_t* CP = WcT + 8192; const bf16_t* SP = CP + 16384; const bf16_t* NSP = SP + 16384; bf16_t* AP = (bf16_t*)(p.ws + OFF_AP);
#pragma unroll 1
  for (int mb = 0; mb < 2; ++mb) {
    bf16x8 vf[4][2][2];
    { bf16x8 wfr[2][4];
#pragma unroll
      for (int part = 0; part < 2; ++part)
#pragma unroll
        for (int s = 0; s < 4; ++s) wfr[part][s] = *(const bf16x8*)(WcT + (64 * part + 32 * mb + r) * 64 + 16 * s + 8 * hh);
#pragma unroll
      for (int rb = 0; rb < 4; ++rb) { const size_t token = (size_t)b * 16384 + 128 * (32 * rb + r) + n2; bf16x8 uf[4];
#pragma unroll
        for (int s = 0; s < 4; ++s) uf[s] = *(const bf16x8*)(PM + token * LDPM + PM_AX + g * 64 + 16 * s + 8 * hh);
#pragma unroll
        for (int part = 0; part < 2; ++part) { f32x16 v = splat16(0.f);
#pragma unroll
          for (int s = 0; s < 4; ++s) v = MFMA32(uf[s], wfr[part][s], v);
          vf[rb][0][part] = pack8(v, 0); vf[rb][1][part] = pack8(v, 1); } } }
#pragma unroll 1
    for (int kq = 0; kq < 4; ++kq) {
      f32x16 Ar = splat16(0.f), Ai = splat16(0.f);
#pragma unroll
      for (int rb = 0; rb < 4; ++rb)
#pragma unroll
        for (int sx = 0; sx < 2; ++sx) { const int pos = (32 * kq + r) * 128 + 32 * rb + 16 * sx + 8 * hh;
          const bf16x8 cf = *(const bf16x8*)(CP + pos), sf = *(const bf16x8*)(SP + pos), nsf = *(const bf16x8*)(NSP + pos);
          Ar = MFMA32(cf, vf[rb][sx][0], Ar); Ar = MFMA32(sf, vf[rb][sx][1], Ar);
          Ai = MFMA32(cf, vf[rb][sx][1], Ai); Ai = MFMA32(nsf, vf[rb][sx][0], Ai); }
#pragma unroll
      for (int i = 0; i < 16; ++i) { const int k1 = 32 * kq + crow(i, hh); const float rev = (float)(n2 * k1) * (1.f / 16384.f); const float cs = cosrev(rev), sn = sinrev(rev);
        const float ar = Ar[i] * cs + Ai[i] * sn, ai = Ai[i] * cs - Ar[i] * sn;
        const size_t o = ((((size_t)b * 128 + k1) * 6 + g) * 128 + n2) * 128 + 32 * mb + r; AP[o] = f2bf(ar); AP[o + 64] = f2bf(ai); }
    }
  }
}

DI void fourierB_item(const Params& p, int b, int k1, int g, lds8* lds) {
  const int tid = launder_tid(), lane = tid & 63, w = tid >> 6, r = lane & 31, hh = lane >> 5, mb = w & 1, kq = w >> 1;
  const bf16_t* X = (const bf16_t*)(p.ws + OFF_AP) + (((size_t)b * 128 + k1) * 6 + g) * 16384;
  const bf16_t* CN = (const bf16_t*)(p.ws + OFF_TAB) + 8192 + 3 * 16384; const bf16_t* SN = CN + 16384; bf16_t* Y = (bf16_t*)(p.ws + OFF_Y);
#pragma unroll
  for (int i = 0; i < 4; ++i) { const int e = tid + NT * i, row = e >> 4, ch = e & 15; *(LAS u32x4*)(lds + row * 272 + ch * 16) = *(const u32x4*)(X + row * 128 + ch * 8); }
  __syncthreads();
  f32x16 F = splat16(0.f);
#pragma unroll
  for (int s = 0; s < 8; ++s) {
    const bf16x8 cf = *(const bf16x8*)(CN + (32 * kq + r) * 128 + 16 * s + 8 * hh), sf = *(const bf16x8*)(SN + (32 * kq + r) * 128 + 16 * s + 8 * hh);
    bf16x8 xr, xi;
#pragma unroll
    for (int j = 0; j < 8; ++j) { const int row = 16 * s + 8 * hh + j; xr[j] = *(const LAS short*)(lds + row * 272 + (32 * mb + r) * 2); xi[j] = *(const LAS short*)(lds + row * 272 + (64 + 32 * mb + r) * 2); }
    F = MFMA32(cf, xr, F); F = MFMA32(sf, xi, F);
  }
#pragma unroll
  for (int i = 0; i < 16; ++i) { const int k2 = 32 * kq + crow(i, hh); const size_t idx = ((size_t)b * 16384 + k1 + 128 * k2) * LDY + Y_A + g * 64 + 32 * mb + r;
    Y[idx] = f2bf(F[i] * (1.f / 1024.f) * bf2f(Y[idx])); }
  __syncthreads();
}

DI void fourierB_wave(const Params& p, int b, int k1, int g, int mb, int w, int lane, lds8* lds) {
  const int r = lane & 31, hh = lane >> 5;
  const bf16_t* X = (const bf16_t*)(p.ws + OFF_AP) + (((size_t)b * 128 + k1) * 6 + g) * 16384;
  const bf16_t* CN = (const bf16_t*)(p.ws + OFF_TAB) + 8192 + 3 * 16384; const bf16_t* SN = CN + 16384; bf16_t* Y = (bf16_t*)(p.ws + OFF_Y);
  lds8* slab = lds + w * 17408;
#pragma unroll
  for (int i = 0; i < 16; ++i) { const int e = lane + 64 * i, row = e >> 3, c = e & 7;
    const u32x4 v = *(const u32x4*)(X + row * 128 + (c < 4 ? 32 * mb + c * 8 : 64 + 32 * mb + (c - 4) * 8));
    *(LAS u32x2*)(slab + row * 136 + c * 16) = (u32x2){v.x, v.y}; *(LAS u32x2*)(slab + row * 136 + c * 16 + 8) = (u32x2){v.z, v.w}; }
  bf16x8 xr[8], xi[8];
#pragma unroll
  for (int s = 0; s < 8; ++s)
#pragma unroll
    for (int j = 0; j < 8; ++j) { const int row = 16 * s + 8 * hh + j; xr[s][j] = *(const LAS short*)(slab + row * 136 + r * 2); xi[s][j] = *(const LAS short*)(slab + row * 136 + 64 + r * 2); }
#pragma unroll 1
  for (int kq = 0; kq < 4; ++kq) {
    f32x16 F = splat16(0.f);
#pragma unroll
    for (int s = 0; s < 8; ++s) {
      const bf16x8 cf = *(const bf16x8*)(CN + (32 * kq + r) * 128 + 16 * s + 8 * hh), sf = *(const bf16x8*)(SN + (32 * kq + r) * 128 + 16 * s + 8 * hh);
      F = MFMA32(cf, xr[s], F); F = MFMA32(sf, xi[s], F); }
#pragma unroll
    for (int i = 0; i < 16; ++i) { const int k2 = 32 * kq + crow(i, hh); const size_t idx = ((size_t)b * 16384 + k1 + 128 * k2) * LDY + Y_A + g * 64 + 32 * mb + r;
      Y[idx] = f2bf(F[i] * (1.f / 1024.f) * bf2f(Y[idx])); }
  }
}

DI void fourierC_item(const Params& p, int b, int g, int kc, lds8* lds) {
  const int tid = launder_tid();
  LAS float* V = (LAS float*)lds; LAS float* T64c = V + 32768; LAS float* T64s = T64c + 64; LAS float* T256c = T64s + 64; LAS float* T256s = T256c + 256;
  const bf16_t* PM = (const bf16_t*)(p.ws + OFF_PM); bf16_t* Y = (bf16_t*)(p.ws + OFF_Y);
  if (tid < 64) { T64c[tid] = cosrev((float)tid * (1.f / 64.f)); T64s[tid] = sinrev((float)tid * (1.f / 64.f)); }
  if (tid < 256) { T256c[tid] = cosrev((float)tid * (1.f / 256.f)); T256s[tid] = sinrev((float)tid * (1.f / 256.f)); }
  __syncthreads();
  for (int e = tid; e < 32768; e += NT) { const int n = e >> 7, mp = e & 127, m = mp & 63;
    const bf16_t* up = PM + (size_t)(TL + b * 256 + n) * LDPM + PM_AX + g * 64; float a = 0.f;
    for (int c8 = 0; c8 < 64; c8 += 8) { float u[8]; unpack8(*(const u32x4*)(up + c8), u);
#pragma unroll
      for (int j = 0; j < 8; ++j) { const int t = (m * (c8 + j)) & 63; a += u[j] * (mp < 64 ? T64c[t] : -T64s[t]); } }
    V[e] = a; }
  __syncthreads();
#pragma unroll
  for (int i = 0; i < 4; ++i) { const int e = tid + NT * i; const int k = kc * 32 + (e >> 6), m = e & 63; float a = 0.f;
    for (int n = 0; n < 256; ++n) { const int t = (k * n) & 255; a += T256c[t] * V[n * 128 + m] + T256s[t] * V[n * 128 + 64 + m]; }
    const size_t idx = (size_t)(TL + b * 256 + k) * LDY + Y_A + g * 64 + m; Y[idx] = f2bf(a * (1.f / 128.f) * bf2f(Y[idx])); }
  __syncthreads();
}

DI void fourierC_stage1(const Params& p, lds8* lds) {
  const int tid = launder_tid(); LAS float* T = (LAS float*)lds;
  const bf16_t* PM = (const bf16_t*)(p.ws + OFF_PM); float* VC = (float*)(p.ws + OFF_VC);
  __syncthreads();
  if (tid < 64) { T[tid] = cosrev((float)tid * (1.f / 64.f)); T[64 + tid] = sinrev((float)tid * (1.f / 64.f)); }
  __syncthreads();
  for (int e = blockIdx.x * NT + tid; e < 2 * 256 * 6 * 128; e += gridDim.x * NT) {
    const int mp = e & 127, g = (e >> 7) % 6, n = (e / 768) & 255, b = e / (768 * 256), m = mp & 63;
    const bf16_t* up = PM + (size_t)(TL + b * 256 + n) * LDPM + PM_AX + g * 64; float a = 0.f;
    for (int c8 = 0; c8 < 64; c8 += 8) { float u[8]; unpack8(*(const u32x4*)(up + c8), u);
#pragma unroll
      for (int j = 0; j < 8; ++j) { const int t = (m * (c8 + j)) & 63; a += u[j] * (mp < 64 ? T[t] : -T[64 + t]); } }
    VC[e] = a; }
  __syncthreads();
}
DI void fourierC_stage2(const Params& p, lds8* lds) {
  const int tid = launder_tid(); LAS float* T = (LAS float*)lds;
  const float* VC = (const float*)(p.ws + OFF_VC); bf16_t* Y = (bf16_t*)(p.ws + OFF_Y);
  __syncthreads();
  if (tid < 256) { T[tid] = cosrev((float)tid * (1.f / 256.f)); T[256 + tid] = sinrev((float)tid * (1.f / 256.f)); }
  __syncthreads();
  for (int e = blockIdx.x * NT + tid; e < 2 * 256 * 6 * 64; e += gridDim.x * NT) {
    const int m = e & 63, g = (e >> 6) % 6, k = (e / 384) & 255, b = e / (384 * 256);
    const float* vp = VC + ((size_t)(b * 256) * 6 + g) * 128 + m; float a = 0.f;
#pragma unroll 8
    for (int n = 0; n < 256; ++n) { const int t = (k * n) & 255; a += T[t] * vp[(size_t)n * 768] + T[256 + t] * vp[(size_t)n * 768 + 64]; }
    const size_t idx = (size_t)(TL + b * 256 + k) * LDY + Y_A + g * 64 + m; Y[idx] = f2bf(a * (1.f / 128.f) * bf2f(Y[idx])); }
  __syncthreads();
}

DI void q_prep(bf16x8 (&qf)[4], const float* __restrict__ gain, bool rope, int prow, int pcol, int hh, const float* __restrict__ RT) {
  float y[4][8]; float ss = 0.f;
#pragma unroll
  for (int s = 0; s < 4; ++s)
#pragma unroll
    for (int j = 0; j < 8; ++j) { y[s][j] = bf2f((bf16_t)qf[s][j]); ss += y[s][j] * y[s][j]; }
  ss = sum32(ss);
  const float rs = rsqrtf(ss * (1.f / 64.f) + 1e-6f);
#pragma unroll
  for (int s = 0; s < 4; ++s) { const f32x4 g0 = *(const f32x4*)(gain + 16 * s + 8 * hh), g1 = *(const f32x4*)(gain + 16 * s + 8 * hh + 4);
    y[s][0] *= rs * g0[0]; y[s][1] *= rs * g0[1]; y[s][2] *= rs * g0[2]; y[s][3] *= rs * g0[3]; y[s][4] *= rs * g1[0]; y[s][5] *= rs * g1[1]; y[s][6] *= rs * g1[2]; y[s][7] *= rs * g1[3]; }
  if (rope) {
    const f32x4* cr = (const f32x4*)(RT + 2 * (prow * 16 + 8 * hh)); const f32x4* cc = (const f32x4*)(RT + 2 * (pcol * 16 + 8 * hh));
#pragma unroll
    for (int q = 0; q < 4; ++q) { const f32x4 a4 = cr[q], b4 = cc[q];
#pragma unroll
      for (int e = 0; e < 2; ++e) { const int jj = 2 * q + e; const float c1 = a4[2 * e], s1 = a4[2 * e + 1], c2 = b4[2 * e], s2 = b4[2 * e + 1];
        const float t1 = y[0][jj], t2 = y[1][jj], t3 = y[2][jj], t4 = y[3][jj];
        y[0][jj] = t1 * c1 - t2 * s1; y[1][jj] = t2 * c1 + t1 * s1; y[2][jj] = t3 * c2 - t4 * s2; y[3][jj] = t4 * c2 + t3 * s2; } }
  }
#pragma unroll
  for (int s = 0; s < 4; ++s) { u32x4 w; w.x = pk2(y[s][0] * QSCALE, y[s][1] * QSCALE); w.y = pk2(y[s][2] * QSCALE, y[s][3] * QSCALE); w.z = pk2(y[s][4] * QSCALE, y[s][5] * QSCALE); w.w = pk2(y[s][6] * QSCALE, y[s][7] * QSCALE);
    qf[s] = __builtin_bit_cast(bf16x8, w); }
}

constexpr int KP = 144;
template <int NDB>
DI void attn_tile(const lds8* kb_, const lds8* vb_, const bf16x8 (&qf)[4], f32x16 (&O)[NDB], float& lsum, float negM, int mmode, int qi, int koff, int r, int pr, int hh) {
  f32x16 S[2];
#pragma unroll
  for (int kb = 0; kb < 2; ++kb) { S[kb] = splat16(negM);
#pragma unroll
    for (int s = 0; s < 4; ++s) { const bf16x8 kf = *(const LAS bf16x8*)(kb_ + (32 * kb + pr) * KP + (16 * s + 8 * hh) * 2); S[kb] = MFMA32(kf, qf[s], S[kb]); } }
  if (mmode != 0) {
#pragma unroll
    for (int kb = 0; kb < 2; ++kb)
#pragma unroll
      for (int i = 0; i < 16; ++i) { const int kj = koff + 32 * kb + 16 * (i >> 3) + 8 * hh + (i & 7); const bool ok = mmode == 1 ? (kj >= qi) : (kj <= qi); if (!ok) S[kb][i] = -1e30f; }
  }
#pragma unroll
  for (int kb = 0; kb < 2; ++kb)
#pragma unroll
    for (int i = 0; i < 16; ++i) { const float pv = __builtin_amdgcn_exp2f(S[kb][i]); lsum += pv; S[kb][i] = pv; }
#pragma unroll
  for (int kb = 0; kb < 2; ++kb)
#pragma unroll
    for (int s = 0; s < 2; ++s) { const bf16x8 pf = pack8(S[kb], s);
#pragma unroll
      for (int db = 0; db < NDB; ++db) { const bf16x8 vfr = *(const LAS bf16x8*)(vb_ + (32 * db + r) * KP + (32 * kb + 16 * s + 8 * hh) * 2); O[db] = MFMA32(vfr, pf, O[db]); } }
}

DI float gain_max(const float* g, int lane) { float v = fabsf(g[lane]);
  v = wave_max(v);
  return v; }

constexpr int DSTG = 65536;
DI void attn_diff_item(const Params& p, int l, int b, int h, int qb, bool ctxq, lds8* lds) {
  const int tid = launder_tid(), lane = tid & 63, w = tid >> 6, r = lane & 31, hh = lane >> 5;
  const int pr = (r & ~12) | ((r & 4) << 1) | ((r & 8) >> 1);
  const bf16_t* PM = (const bf16_t*)(p.ws + OFF_PM); const bf16_t* VTD = (const bf16_t*)(p.ws + OFF_VTD); bf16_t* Y = (bf16_t*)(p.ws + OFF_Y);
  const size_t qrow = (size_t)(ctxq ? TL + b * 256 : b * 16384) + qb * 256 + w * 32 + r;
  bf16x8 qf[2][4];
#pragma unroll
  for (int c = 0; c < 2; ++c)
#pragma unroll
    for (int s = 0; s < 4; ++s) qf[c][s] = *(const bf16x8*)(PM + qrow * LDPM + PM_DQ + h * 128 + c * 64 + 16 * s + 8 * hh);
  { const int nq = (int)qrow & 16383; const float* RTq = (const float*)(p.ws + OFF_ROPE);
    q_prep(qf[0], p.q_norm_d + l * 64, !ctxq, nq >> 6, nq & 63, hh, RTq); q_prep(qf[1], p.q_norm_d + l * 64, !ctxq, nq >> 6, nq & 63, hh, RTq); }
  f32x16 O1[4], O2[4];
#pragma unroll
  for (int d = 0; d < 4; ++d) { O1[d] = splat16(0.f); O2[d] = splat16(0.f); }
  float ls1 = 0.f, ls2 = 0.f;
  const int nt = ctxq ? 2 : 130;
  const char* kbu = (const char*)(PM + (size_t)(TL + b * 256) * LDPM + PM_DK + h * 128);
  const char* kbu_lat = (const char*)(PM + (size_t)(b * 16384) * LDPM + PM_DK + h * 128);
  const char* vbu = (const char*)(VTD + (size_t)(b * 4 + h) * 128 * NKEY);
#define DSTAGE(buf_) do { const int t_ = launder_tid(); const int lr_ = t_ >> 3, lc_ = (t_ & 7) ^ ((lr_ >> 1) & 7), vr_ = t_ >> 4, vc_ = (t_ & 15) ^ (vr_ & 15); \
    const unsigned kvo = (unsigned)((lr_ * LDPM + lc_ * 8) * 2), vvo = (unsigned)((vr_ * NKEY + vc_ * 8) * 2); lds8* b__ = lds + t_ * 16 + (buf_) * DSTG; \
    __builtin_amdgcn_global_load_lds((const unsigned*)(kbu + kvo), (LAS unsigned*)b__, 16, 0, 0); __builtin_amdgcn_sched_barrier(0); \
    __builtin_amdgcn_global_load_lds((const unsigned*)(kbu + (size_t)64 * LDPM * 2 + kvo), (LAS unsigned*)(b__ + 8192), 16, 0, 0); __builtin_amdgcn_sched_barrier(0); \
    __builtin_amdgcn_global_load_lds((const unsigned*)(kbu + 128 + kvo), (LAS unsigned*)(b__ + 16384), 16, 0, 0); __builtin_amdgcn_sched_barrier(0); \
    __builtin_amdgcn_global_load_lds((const unsigned*)(kbu + (size_t)64 * LDPM * 2 + 128 + kvo), (LAS unsigned*)(b__ + 24576), 16, 0, 0); __builtin_amdgcn_sched_barrier(0); \
    __builtin_amdgcn_global_load_lds((const unsigned*)(vbu + vvo), (LAS unsigned*)(b__ + 32768), 16, 0, 0); __builtin_amdgcn_sched_barrier(0); \
    __builtin_amdgcn_global_load_lds((const unsigned*)(vbu + (size_t)32 * NKEY * 2 + vvo), (LAS unsigned*)(b__ + 40960), 16, 0, 0); __builtin_amdgcn_sched_barrier(0); \
    __builtin_amdgcn_global_load_lds((const unsigned*)(vbu + (size_t)64 * NKEY * 2 + vvo), (LAS unsigned*)(b__ + 49152), 16, 0, 0); __builtin_amdgcn_sched_barrier(0); \
    __builtin_amdgcn_global_load_lds((const unsigned*)(vbu + (size_t)96 * NKEY * 2 + vvo), (LAS unsigned*)(b__ + 57344), 16, 0, 0); __builtin_amdgcn_sched_barrier(0); \
    kbu += (size_t)128 * LDPM * 2; vbu += 256; } while (0)
  const int ksw = (pr >> 1) & 7, vsw = r & 15;
  int koff[4], voff[2];
#pragma unroll
  for (int s = 0; s < 4; ++s) koff[s] = pr * 128 + (((2 * s + hh) ^ ksw) << 4);
#pragma unroll
  for (int s = 0; s < 2; ++s) voff[s] = r * 256 + (((2 * s + hh) ^ vsw) << 4);
#define DBODY(cur_) do { \
    _Pragma("unroll 1") for (int kb = 0; kb < 4; ++kb) { \
      __builtin_amdgcn_iglp_opt(0); \
      bf16x8 P1[2], P2[2]; \
      _Pragma("unroll") for (int c = 0; c < 2; ++c) { \
        f32x16 S = splat16(0.f); \
        _Pragma("unroll") for (int s = 0; s < 4; ++s) { const bf16x8 kf = *(const LAS bf16x8*)(lds + c * 16384 + kb * 4096 + koff[s]); S = MFMA32(kf, qf[c][s], S); } \
        float ls = 0.f; \
        _Pragma("unroll") for (int i = 0; i < 16; ++i) { const float pv = __builtin_amdgcn_exp2f(S[i]); ls += pv; S[i] = pv; } \
        if (c == 0) { ls1 += ls; P1[0] = pack8(S, 0); P1[1] = pack8(S, 1); } else { ls2 += ls; P2[0] = pack8(S, 0); P2[1] = pack8(S, 1); } \
      } \
      _Pragma("unroll") for (int s = 0; s < 2; ++s) { \
        _Pragma("unroll") for (int db = 0; db < 4; ++db) { const bf16x8 vfr = *(const LAS bf16x8*)(lds + 32768 + db * 8192 + (voff[s] ^ (kb << 6))); \
          O1[db] = MFMA32(vfr, P1[s], O1[db]); O2[db] = MFMA32(vfr, P2[s], O2[db]); } } \
    } \
    _Pragma("unroll") for (int s = 0; s < 4; ++s) { koff[s] ^= DSTG; asm volatile("" : "+v"(koff[s])); } \
    _Pragma("unroll") for (int s = 0; s < 2; ++s) { voff[s] ^= DSTG; asm volatile("" : "+v"(voff[s])); } \
  } while (0)
  DSTAGE(0);
  asm volatile("s_waitcnt vmcnt(0)" ::: "memory"); __syncthreads();
#pragma unroll 1
  for (int t = 0; t < nt; t += 2) {
    DSTAGE(1);
    if (t + 2 == 2) kbu = kbu_lat;
    DBODY(0);
    asm volatile("s_waitcnt vmcnt(0)" ::: "memory"); __syncthreads();
    if (t + 2 < nt) DSTAGE(0);
    DBODY(1);
    asm volatile("s_waitcnt vmcnt(0)" ::: "memory"); __syncthreads();
  }
#undef DSTAGE
#undef DBODY
  const int tid2 = launder_tid(), lane2 = tid2 & 63, w2 = tid2 >> 6, r2 = lane2 & 31, hh2 = lane2 >> 5;
  const size_t qrow2 = (size_t)(ctxq ? TL + b * 256 : b * 16384) + qb * 256 + w2 * 32 + r2;
  ls1 = sum32(ls1); ls2 = sum32(ls2);
  float la = p.lam_q1[l * 64 + lane2] * p.lam_k1[l * 64 + lane2], lb = p.lam_q2[l * 64 + lane2] * p.lam_k2[l * 64 + lane2];
  la = wave_sum(la); lb = wave_sum(lb);
  const float lam_init = l == 0 ? 0.2f : (0.8f - 0.6f * 0.7408182206817179f);
  const float lam = __expf(la) - __expf(lb) + lam_init;
  const float i1 = 1.f / ls1, i2 = lam / ls2;
  float ss = 0.f;
#pragma unroll
  for (int d = 0; d < 4; ++d)
#pragma unroll
    for (int i = 0; i < 16; ++i) { const float o = O1[d][i] * i1 - O2[d][i] * i2; O1[d][i] = o; ss += o * o; }
  ss = sum32(ss);
  const float rs = rsqrtf(ss * (1.f / 128.f) + 1e-6f) * (1.f - lam_init);
  const float* sg = p.subln_d + l * 128;
  bf16_t* yrow = (bf16_t*)(p.ws + OFF_Y) + qrow2 * LDY + Y_D + h * 128;
#pragma unroll
  for (int d = 0; d < 4; ++d)
#pragma unroll
    for (int a = 0; a < 4; ++a) { const int dv = 32 * d + 8 * a + 4 * hh2; const u32x2 szr = *(const u32x2*)(yrow + dv); const f32x4 g4 = *(const f32x4*)(sg + dv);
      u32x2 o; o.x = pk2(O1[d][4 * a + 0] * rs * g4[0] * bflo(szr.x), O1[d][4 * a + 1] * rs * g4[1] * bfhi(szr.x));
      o.y = pk2(O1[d][4 * a + 2] * rs * g4[2] * bflo(szr.y), O1[d][4 * a + 3] * rs * g4[3] * bfhi(szr.y)); *(u32x2*)(yrow + dv) = o; }
  __syncthreads();
}

constexpr int SSTG = 18432;
DI void attn_swa_item(const Params& p, int l, int b, int hk, int blk, bool ctxq, lds8* lds) {
  const int tid = launder_tid(), lane = tid & 63, w = tid >> 6, r = lane & 31, hh = lane >> 5, rg = w & 3, hp = w >> 2;
  const int pr = (r & ~12) | ((r & 4) << 1) | ((r & 8) >> 1);
  const bf16_t* PM = (const bf16_t*)(p.ws + OFF_PM); const bf16_t* VTB = (const bf16_t*)(p.ws + OFF_VTB); bf16_t* Y = (bf16_t*)(p.ws + OFF_Y);
  constexpr float negM = 0.f;
  const size_t qrow = (size_t)(ctxq ? TL + b * 256 : b * 16384) + blk * 128 + rg * 32 + r;
  const int qi = rg * 32 + r;
  const int lrow = tid >> 3, lch = tid & 7;
  const bf16_t* vbase = VTB + ((size_t)(b * 2 + hk) * 64 + lrow) * NKEY + lch * 8;
  const int nt = ctxq ? 4 : 10;
  {
    const int hq = hk * 4 + hp * 2;
    bf16x8 qf0[4], qf1[4];
#pragma unroll
    for (int s = 0; s < 4; ++s) { qf0[s] = *(const bf16x8*)(PM + qrow * LDPM + PM_BQ + hq * 64 + 16 * s + 8 * hh); qf1[s] = *(const bf16x8*)(PM + qrow * LDPM + PM_BQ + (hq + 1) * 64 + 16 * s + 8 * hh); }
    { const int nq = (int)qrow & 16383; const float* RTq = (const float*)(p.ws + OFF_ROPE);
      q_prep(qf0, p.q_norm_b + l * 64, !ctxq, nq >> 6, nq & 63, hh, RTq); q_prep(qf1, p.q_norm_b + l * 64, !ctxq, nq >> 6, nq & 63, hh, RTq); }
    f32x16 O0[2], O1[2]; O0[0] = splat16(0.f); O0[1] = splat16(0.f); O1[0] = splat16(0.f); O1[1] = splat16(0.f);
    float ls0 = 0.f, ls1 = 0.f;
#define SWA_VALID(t_) ((t_) < 4 || (t_) == 6 || (t_) == 7 || ((t_) < 6 ? blk > 0 : blk < 127))
#define SWA_LOAD(t_) do { const int t__ = (t_); int krow0, key0; \
      if (t__ < 4) { krow0 = TL + b * 256 + t__ * 64; key0 = t__ * 64; } \
      else { const int bb = blk + ((t__ - 4) >> 1) - 1; const int nn = bb * 128 + ((t__ - 4) & 1) * 64; krow0 = b * 16384 + nn; key0 = 256 + nn; } \
      st0 = *(const u32x4*)(PM + (size_t)(krow0 + lrow) * LDPM + PM_BK + hk * 64 + lch * 8); st1 = *(const u32x4*)(vbase + key0); } while (0)
    u32x4 st0, st1; int t = 0, cur = 0;
    SWA_LOAD(0);
#pragma unroll 1
    while (t < nt) {
      lds8* bb_ = lds + cur * SSTG;
      *(LAS u32x4*)(bb_ + lrow * KP + lch * 16) = st0; *(LAS u32x4*)(bb_ + 9216 + lrow * KP + lch * 16) = st1;
      __syncthreads();
      int tn = t + 1; while (tn < nt && !SWA_VALID(tn)) ++tn;
      if (tn < nt) SWA_LOAD(tn);
      const int mmode = t < 4 ? 0 : (t < 6 ? 1 : (t < 8 ? 0 : 2)); const int koff = t < 4 ? 0 : ((t - 4) & 1) * 64;
      attn_tile<2>(bb_, bb_ + 9216, qf0, O0, ls0, negM, mmode, qi, koff, r, pr, hh);
      __builtin_amdgcn_sched_barrier(0);
      attn_tile<2>(bb_, bb_ + 9216, qf1, O1, ls1, negM, mmode, qi, koff, r, pr, hh);
      __builtin_amdgcn_sched_barrier(0);
      cur ^= 1; t = tn;
    }
#undef SWA_VALID
#undef SWA_LOAD
    ls0 = sum32(ls0); ls1 = sum32(ls1);
    ls0 += __builtin_amdgcn_exp2f(p.sink_b[l * 8 + hq] * LOG2E); ls1 += __builtin_amdgcn_exp2f(p.sink_b[l * 8 + hq + 1] * LOG2E);
    const float i0 = 1.f / ls0, i1 = 1.f / ls1;
    bf16_t* yrow = Y + qrow * LDY + Y_B + hq * 64;
#pragma unroll
    for (int d = 0; d < 2; ++d)
#pragma unroll
      for (int a = 0; a < 4; ++a) { const int dv = 32 * d + 8 * a + 4 * hh;
        { const u32x2 szr = *(const u32x2*)(yrow + dv); u32x2 o; o.x = pk2(O0[d][4 * a + 0] * i0 * bflo(szr.x), O0[d][4 * a + 1] * i0 * bfhi(szr.x)); o.y = pk2(O0[d][4 * a + 2] * i0 * bflo(szr.y), O0[d][4 * a + 3] * i0 * bfhi(szr.y)); *(u32x2*)(yrow + dv) = o; }
        { const u32x2 szr = *(const u32x2*)(yrow + 64 + dv); u32x2 o; o.x = pk2(O1[d][4 * a + 0] * i1 * bflo(szr.x), O1[d][4 * a + 1] * i1 * bfhi(szr.x)); o.y = pk2(O1[d][4 * a + 2] * i1 * bflo(szr.y), O1[d][4 * a + 3] * i1 * bfhi(szr.y)); *(u32x2*)(yrow + 64 + dv) = o; } }
    __syncthreads();
  }
}

DI void phase_elem(const Params& p, int l, lds8* lds) {
  const int tid = launder_tid(), lane = tid & 63, w = tid >> 6;
  normrope_phase(p, l, w, lane);
  for (int it = blockIdx.x * NT + tid; it < TT * 48; it += gridDim.x * NT) conv_item(p, l, it);
  for (int it = blockIdx.x; it < 1536; it += gridDim.x) { const int g = it % 6, n2 = (it / 6) % 128, b = it / 768; fourierA_item(p, b, n2, g); }
  if (l == 0) for (int it = blockIdx.x; it < 96; it += gridDim.x) { const int kc = it & 7, g = (it >> 3) % 6, b = it / 48; fourierC_item(p, b, g, kc, lds); }
}

DI void phase_mix(const Params& p, int l, lds8* lds) {
  for (int it = blockIdx.x; it < 512; it += gridDim.x) { const int bh = it & 7, qb = it >> 3; attn_diff_item(p, l, bh >> 2, bh & 3, qb, false, lds); }
  for (int it = blockIdx.x; it < 512; it += gridDim.x) { const int bk = it & 3, blk = it >> 2; attn_swa_item(p, l, bk >> 1, bk & 1, blk, false, lds); }
  for (int it = blockIdx.x; it < 1536; it += gridDim.x) { const int g = it % 6, k1 = (it / 6) % 128, b = it / 768; fourierB_item(p, b, k1, g, lds); }
  if (l == 0) {
    for (int it = blockIdx.x; it < 8; it += gridDim.x) { const int bh = it & 7; attn_diff_item(p, l, bh >> 2, bh & 3, 0, true, lds); }
    for (int it = blockIdx.x; it < 8; it += gridDim.x) { const int bk = it & 3, blk = it >> 2; attn_swa_item(p, l, bk >> 1, bk & 1, blk, true, lds); }
  }
}

struct GateCtx {
  const Params& p; int G, bid, l;
  int u, sub;
  DI bool next(int, g8::Desc& d) {
    int pm, pn; bool ctx = false;
    if (u < 2) unit_next(128, 4, u * G + bid, pm, pn);
    else return false;
    const int br = sub >> 1;
    d.pm = pm; d.pn = pn; d.aux = sub | (ctx ? 8 : 0);
    if ((sub & 1) == 0) { d.A = (const char*)(p.ws + OFF_H) + (size_t)pm * 256 * 1024 * 2; d.B = (const char*)(p.ws + OFF_WIN) + (size_t)(5632 + br * 1024 + pn * 256) * 1024 * 2; d.lda = 1024; d.ldb = 1024; d.nt = 16; }
    else { const int Kb = (br & 1) ? 512 : 384; const int ycol = br == 0 ? Y_A : (br == 1 ? Y_B : (br == 2 ? Y_C : Y_D));
      const size_t wooff = br == 0 ? 0 : (br == 1 ? 393216 : (br == 2 ? 917504 : 1310720));
      d.A = (const char*)(p.ws + OFF_Y) + ((size_t)pm * 256 * LDY + ycol) * 2; d.B = (const char*)(p.ws + OFF_WO) + (wooff + (size_t)pn * 256 * Kb) * 2; d.lda = LDY; d.ldb = Kb; d.nt = Kb / 64; }
    sub += ctx ? 2 : 1; if (sub >= 8) { sub = 0; ++u; }
    return true; }
  DI void epi(const g8::Desc& d, const f32x4 (&acc)[2][2][4][2]) const {
    const int tid2 = launder_tid();
    u32x2* SGt = (u32x2*)(p.ws + OFF_SCR + (size_t)bid * 393216) + tid2; u32x2* SMt = (u32x2*)(p.ws + OFF_SCR + (size_t)bid * 393216 + 131072) + tid2;
    const int br = (d.aux & 7) >> 1; const bool ctxg = (d.aux & 8) != 0;
    if ((d.aux & 1) == 0) {
#pragma unroll
      for (int ai = 0; ai < 2; ++ai)
#pragma unroll
        for (int bj = 0; bj < 2; ++bj)
#pragma unroll
          for (int m = 0; m < 4; ++m)
#pragma unroll
            for (int n = 0; n < 2; ++n) { const int slot = ((ai * 2 + bj) * 4 + m) * 2 + n; const f32x4 v = acc[ai][bj][m][n];
              u32x2 o; o.x = pk2(sigm(v[0]), sigm(v[1])); o.y = pk2(sigm(v[2]), sigm(v[3])); SGt[slot * NT] = o; }
    } else {
      bf16_t* MIXED = (bf16_t*)(p.ws + OFF_MIXED);
      const int wid2 = tid2 >> 6, lane2 = tid2 & 63, wr2 = wid2 >> 2, wc2 = wid2 & 3, fr2 = lane2 & 15, fq2 = lane2 >> 4;
#pragma unroll
      for (int ai = 0; ai < 2; ++ai)
#pragma unroll
        for (int bj = 0; bj < 2; ++bj)
#pragma unroll
          for (int m = 0; m < 4; ++m)
#pragma unroll
            for (int n = 0; n < 2; ++n) { const int slot = ((ai * 2 + bj) * 4 + m) * 2 + n; const f32x4 v = acc[ai][bj][m][n];
              const int row_ = d.pm * 256 + ai * 128 + wr2 * 64 + m * 16 + fr2, col_ = d.pn * 256 + bj * 128 + wc2 * 32 + n * 16 + fq2 * 4;
              const u32x2 gg = ctxg ? *(const u32x2*)((const bf16_t*)(p.ws + OFF_CG) + (size_t)(row_ - TL) * 4096 + br * 1024 + col_) : SGt[slot * NT]; f32x4 mm = {0.f, 0.f, 0.f, 0.f}; if (br > 0) { const u32x2 mr = SMt[slot * NT]; mm[0] = bflo(mr.x); mm[1] = bfhi(mr.x); mm[2] = bflo(mr.y); mm[3] = bfhi(mr.y); }
              mm[0] += bflo(gg.x) * v[0]; mm[1] += bfhi(gg.x) * v[1]; mm[2] += bflo(gg.y) * v[2]; mm[3] += bfhi(gg.y) * v[3];
              u32x2 mo; mo.x = pk2(mm[0], mm[1]); mo.y = pk2(mm[2], mm[3]);
              if (br < 3) SMt[slot * NT] = mo;
              else { const int row = d.pm * 256 + ai * 128 + wr2 * 64 + m * 16 + fr2, col = d.pn * 256 + bj * 128 + wc2 * 32 + n * 16 + fq2 * 4; *(u32x2*)(MIXED + (size_t)row * 1024 + col) = mo; } }
    }
  }
};
DI void ctx_merge_tasks(const Params& p) {
  const int tid = launder_tid(), lane = tid & 63, w = tid >> 6, r = lane & 31, hh = lane >> 5;
  const bf16_t* Y = (const bf16_t*)(p.ws + OFF_Y); const bf16_t* WO = (const bf16_t*)(p.ws + OFF_WO); const bf16_t* CG = (const bf16_t*)(p.ws + OFF_CG); bf16_t* MIXED = (bf16_t*)(p.ws + OFF_MIXED);
  for (int tk = w * gridDim.x + blockIdx.x; tk < 512; tk += 8 * gridDim.x) {
    const int rb = tk >> 5, cb = tk & 31;
    f32x16 mm = splat16(0.f);
#pragma unroll 1
    for (int br = 0; br < 4; ++br) {
      const int Kb = (br & 1) ? 512 : 384; const int ycol = br == 0 ? Y_A : (br == 1 ? Y_B : (br == 2 ? Y_C : Y_D));
      const size_t wooff = br == 0 ? 0 : (br == 1 ? 393216 : (br == 2 ? 917504 : 1310720));
      const bf16_t* ap = Y + (size_t)(TL + 32 * rb + r) * LDY + ycol + 8 * hh; const bf16_t* bp = WO + wooff + (size_t)(32 * cb + r) * Kb + 8 * hh;
      f32x16 acc = splat16(0.f);
#pragma unroll 4
      for (int s = 0; s < Kb / 16; ++s) acc = MFMA32(*(const bf16x8*)(ap + 16 * s), *(const bf16x8*)(bp + 16 * s), acc);
#pragma unroll
      for (int i = 0; i < 16; ++i) mm[i] += bf2f(CG[(size_t)(32 * rb + crow(i, hh)) * 4096 + br * 1024 + 32 * cb + r]) * acc[i];
    }
#pragma unroll
    for (int i = 0; i < 16; ++i) MIXED[(size_t)(TL + 32 * rb + crow(i, hh)) * 1024 + 32 * cb + r] = f2bf(mm[i]);
  }
}
DI void ctx_out_tasks(const Params& p) {
  const int tid = launder_tid(), lane = tid & 63, w = tid >> 6, r = lane & 31, hh = lane >> 5;
  const bf16_t* MIXED = (const bf16_t*)(p.ws + OFF_MIXED); const bf16_t* WOUT = (const bf16_t*)(p.ws + OFF_WOUT); const float* MOD = (const float*)(p.ws + OFF_MOD); float* CTX1 = (float*)(p.ws + OFF_CTX1);
  for (int tk = w * gridDim.x + blockIdx.x; tk < 512; tk += 8 * gridDim.x) {
    const int rb = tk >> 5, cb = tk & 31;
    const bf16_t* ap = MIXED + (size_t)(TL + 32 * rb + r) * 1024 + 8 * hh; const bf16_t* bp = WOUT + (size_t)(32 * cb + r) * 1024 + 8 * hh;
    f32x16 acc = splat16(0.f);
#pragma unroll 4
    for (int s = 0; s < 64; ++s) acc = MFMA32(*(const bf16x8*)(ap + 16 * s), *(const bf16x8*)(bp + 16 * s), acc);
    const float gt = MOD[2 * 3072 + 2048 + 32 * cb + r];
#pragma unroll
    for (int i = 0; i < 16; ++i) { const size_t o = (size_t)(32 * rb + crow(i, hh)) * 1024 + 32 * cb + r; CTX1[o] = p.ctx[o] + gt * acc[i]; }
  }
}
DI void phase_gate(const Params& p, int l, lds8* lds) { GateCtx c{p, (int)gridDim.x, (int)blockIdx.x, l, 0, 0}; g8::gemm_stream(lds, c); if (l == 0) ctx_merge_tasks(p); }

struct OutCtx {
  const Params& p; int G, bid, nM, l;
  DI bool next(int ui, g8::Desc& d) const {
    int pm, pn; if (!unit_next(nM, 4, ui * G + bid, pm, pn)) return false;
    d.A = (const char*)(p.ws + OFF_MIXED) + (size_t)pm * 256 * 1024 * 2; d.B = (const char*)(p.ws + OFF_WOUT) + ((size_t)l * 1048576 + (size_t)pn * 256 * 1024) * 2;
    d.lda = 1024; d.ldb = 1024; d.nt = 16; d.pm = pm; d.pn = pn; d.aux = 0; return true; }
  DI void epi(const g8::Desc& d, const f32x4 (&acc)[2][2][4][2]) const {
    const int tid = launder_tid(), wid = tid >> 6, lane = tid & 63, wr = wid >> 2, wc = wid & 3, fr = lane & 15, fq = lane >> 4;
    const float* MOD = (const float*)(p.ws + OFF_MOD); float* CTX1 = (float*)(p.ws + OFF_CTX1);
    const float* xl = l == 0 ? p.x : p.out;
#pragma unroll
    for (int ai = 0; ai < 2; ++ai)
#pragma unroll
      for (int m = 0; m < 4; ++m) { const int row = d.pm * 256 + ai * 128 + wr * 64 + m * 16 + fr;
        const float* src; float* dst; int v;
        if (row < TL) { src = xl + (size_t)row * 1024; dst = p.out + (size_t)row * 1024; v = row >> 14; } else { src = p.ctx + (size_t)(row - TL) * 1024; dst = CTX1 + (size_t)(row - TL) * 1024; v = 2; }
        const float* gate = MOD + (l * 3 + v) * 3072 + 2048;
#pragma unroll
        for (int bj = 0; bj < 2; ++bj)
#pragma unroll
          for (int n = 0; n < 2; ++n) { const int col = d.pn * 256 + bj * 128 + wc * 32 + n * 16 + fq * 4;
            const f32x4 xv = *(const f32x4*)(src + col), gv = *(const f32x4*)(gate + col); *(f32x4*)(dst + col) = xv + gv * acc[ai][bj][m][n]; } }
  }
};
DI void phase_out(const Params& p, int l, lds8* lds) { OutCtx c{p, (int)gridDim.x, (int)blockIdx.x, 128, l}; g8::gemm_stream(lds, c); if (l == 0) ctx_out_tasks(p); }

#define XB_TMO      128
#define XB_XCNT(j)  (256  + 64 * (j))
#define XB_XSUB(j)  (1280 + 64 * (j))
#define XB_XGEN(j)  (2304 + 64 * (j))
#define XB_TOP      3328
#define XB_TOPGEN   3392
#define XCD_BAR_WORDS 3456
#define XB_SPIN_CAP (1u << 20)
DI unsigned xb_ld(unsigned* p) { return __hip_atomic_load(p, __ATOMIC_RELAXED, __HIP_MEMORY_SCOPE_AGENT); }
DI unsigned xb_add(unsigned* p, unsigned v) { return __hip_atomic_fetch_add(p, v, __ATOMIC_RELAXED, __HIP_MEMORY_SCOPE_AGENT); }
DI unsigned xb_xcc_id() { return (unsigned)__builtin_amdgcn_s_getreg((3 << 11) | 20) & 0xFu; }
#define XB_SPIN(cond, bar) do { unsigned _sp = 0; while (cond) { __builtin_amdgcn_s_sleep(1); \
    if ((++_sp & 255u) == 0u) { if (xb_ld(&(bar)[XB_TMO])) break; if (_sp > XB_SPIN_CAP) { atomicAdd(&(bar)[XB_TMO], 1u); break; } } } } while (0)
struct XcdBarrier { unsigned* bar; unsigned x; volatile LAS unsigned* st; };
DI XcdBarrier xcd_barrier_post(unsigned* bar, volatile LAS unsigned* st) {
  XcdBarrier b; b.bar = bar; b.x = xb_xcc_id(); b.st = st;
  if (threadIdx.x == 0) (void)xb_add(&bar[XB_XCNT(b.x)], 1u);
  return b;
}
DI void xcd_barrier_complete(unsigned* bar, unsigned x, unsigned& nloc, unsigned& nx) {
  const unsigned G = gridDim.x * gridDim.y * gridDim.z;
  unsigned sum, cnt, mine, sp = 0u;
  for (;;) {
    sum = 0u; cnt = 0u; mine = 0u;
#pragma unroll
    for (unsigned j = 0; j < 16; ++j) { const unsigned c = xb_ld(&bar[XB_XCNT(j)]); sum += c; cnt += (c > 0u) ? 1u : 0u; mine = (j == x) ? c : mine; }
    if (sum == G) break;
    __builtin_amdgcn_s_sleep(1);
    if ((++sp & 255u) == 0u) { if (xb_ld(&bar[XB_TMO])) break; if (sp > XB_SPIN_CAP) { atomicAdd(&bar[XB_TMO], 1u); break; } }
  }
  nloc = mine > 0u ? mine : 1u; nx = cnt > 0u ? cnt : 1u;
}
DI void xcd_barrier(const XcdBarrier& b) {
  asm volatile("s_waitcnt vmcnt(0)" ::: "memory");
  __syncthreads();
  if (threadIdx.x == 0) {
    unsigned* bar = b.bar;
    __builtin_amdgcn_s_waitcnt(0);
    unsigned nloc = b.st[0], nx = b.st[1];
    if (nloc == 0u) { xcd_barrier_complete(bar, b.x, nloc, nx); b.st[0] = nloc; b.st[1] = nx; }
    const unsigned old = xb_add(&bar[XB_XSUB(b.x)], 1u);
    const unsigned gen = old / nloc;
    if (old + 1u == (gen + 1u) * nloc) {
      __builtin_amdgcn_fence(__ATOMIC_RELEASE, "agent");
      asm volatile("s_waitcnt vmcnt(0)" ::: "memory");
      const unsigned og = xb_add(&bar[XB_TOP], 1u);
      const unsigned tg = og / nx;
      if (og + 1u == (tg + 1u) * nx) xb_add(&bar[XB_TOPGEN], 1u);
      else XB_SPIN(xb_ld(&bar[XB_TOPGEN]) == tg, bar);
      __builtin_amdgcn_fence(__ATOMIC_ACQUIRE, "agent");
      xb_add(&bar[XB_XGEN(b.x)], 1u);
      asm volatile("s_waitcnt vmcnt(0)" ::: "memory");
    } else {
      XB_SPIN(xb_ld(&bar[XB_XGEN(b.x)]) == gen, bar);
      __builtin_amdgcn_fence(__ATOMIC_ACQUIRE, "agent");
      asm volatile("s_waitcnt vmcnt(0)" ::: "memory");
    }
  }
  __syncthreads();
}

DI int wg_dequeue(unsigned* ctr, lds8* lds) {
  volatile LAS int* slot = (volatile LAS int*)(lds + LDS_BYTES - 8);
  __syncthreads();
  if (threadIdx.x == 0) *slot = (int)__hip_atomic_fetch_add(ctr, 1u, __ATOMIC_RELAXED, __HIP_MEMORY_SCOPE_AGENT);
  __syncthreads();
  return *slot;
}

#ifndef PROBE_MODE
#define PROBE_MODE 0
#endif
#ifndef PROBE_A
#define PROBE_A 0x100
#endif
#ifndef PROBE_B
#define PROBE_B 0x1000
#endif
#if PROBE_MODE
DI unsigned long long ptime_() { unsigned long long t; asm volatile("s_memrealtime %0\n\ts_waitcnt lgkmcnt(0)" : "=s"(t) :: "memory"); return t; }
#define PTIME() ptime_()
#define PACC(cat, t0_) do { const unsigned long long d_ = PTIME() - (t0_); if ((PROBE_A >> (cat)) & 1) tA += d_; if ((PROBE_B >> (cat)) & 1) tB += d_; } while (0)
#else
#define PTIME() 0ull
#define PACC(cat, t0_) do { (void)(t0_); } while (0)
#endif

__global__ void __launch_bounds__(NT) hybrid_fwd(Params p) {
  extern __shared__ __attribute__((aligned(16))) unsigned char lds_raw[];
  lds8* lds = (lds8*)lds_raw;
  cg::grid_group grid = cg::this_grid();
  volatile LAS unsigned* xst = (volatile LAS unsigned*)(lds + LDS_BYTES - 16);
  if (threadIdx.x == 0) { xst[0] = 0u; xst[1] = 0u; }
  __syncthreads();
  if (blockIdx.x == 0) { unsigned* bw = (unsigned*)(p.ws + OFF_BAR); for (int i = threadIdx.x; i < 4096; i += NT) bw[i] = 0u; }
  unsigned long long tA = 0, tB = 0, tq; const unsigned long long tstart = PTIME();
  tq = PTIME();
  for (int it = blockIdx.x; it < PREP_ITEMS + 98; it += gridDim.x) {
    if (it < PREP_ITEMS) prep_item(p, 0, it, lds);
    else if (it < PREP_ITEMS + 96) mod_item(p, it - PREP_ITEMS, lds);
    else tables_item(p, it - PREP_ITEMS - 96);
  }
  grid.sync(); PACC(0, tq);
  const XcdBarrier xbar = xcd_barrier_post((unsigned*)(p.ws + OFF_BAR), xst);
#pragma unroll 1
  for (int l = 0; l < 2; ++l) {
    tq = PTIME(); phase_norm(p, l); xcd_barrier(xbar); PACC(1, tq);
    tq = PTIME(); phase_inproj(p, l, lds); xcd_barrier(xbar); PACC(2, tq);
    tq = PTIME();
    { const int tid_ = launder_tid(), lane_ = tid_ & 63, w_ = tid_ >> 6; unsigned long long t2 = PTIME();
      PACC(10, t2); t2 = PTIME();
      for (int it = blockIdx.x * NT + tid_; it < TT * 48; it += gridDim.x * NT) conv_item(p, l, it);
      PACC(11, t2); t2 = PTIME();
      for (int it = w_ * gridDim.x + blockIdx.x; it < 1536; it += 8 * gridDim.x) { const int g = it % 6, n2 = (it / 6) % 128, b = it / 768; fourierA_wave(p, b, n2, g, lane_); }
      PACC(12, t2); t2 = PTIME();
      if (l == 0) fourierC_stage1(p, lds);
      PACC(13, t2); }
    xcd_barrier(xbar); PACC(3, tq);
    tq = PTIME();
    { unsigned long long t2 = PTIME();
      for (int it = blockIdx.x; it < 512; it += gridDim.x) { const int bh = it & 7, qb = it >> 3; attn_diff_item(p, l, bh >> 2, bh & 3, qb, false, lds); }
      PACC(7, t2); t2 = PTIME();
      {
        unsigned* qctr = (unsigned*)(p.ws + OFF_BAR) + 3520 + 64 * l;
        const int qlim = l == 0 ? 528 : 512;
        for (int it = blockIdx.x; it < qlim; ) {
          if (it < 512) { const int bk = it & 3, blk = it >> 2; attn_swa_item(p, l, bk >> 1, bk & 1, blk, false, lds); }
          else if (it < 520) { const int bh = it - 512; attn_diff_item(p, l, bh >> 2, bh & 3, 0, true, lds); }
          else { const int e = it - 520; const int bk = e & 3, blk = e >> 2; attn_swa_item(p, l, bk >> 1, bk & 1, blk, true, lds); }
          it = (int)gridDim.x + wg_dequeue(qctr, lds); } }
      PACC(8, t2); t2 = PTIME();
      { const int tidb = launder_tid(), wb_ = tidb >> 6, lb_ = tidb & 63;
        for (int it2 = wb_ * gridDim.x + blockIdx.x; it2 < 3072; it2 += 8 * gridDim.x) { const int it = it2 >> 1, g = it % 6, k1 = (it / 6) % 128, b = it / 768; fourierB_wave(p, b, k1, g, it2 & 1, wb_, lb_, lds); }
        __syncthreads(); }
      PACC(9, t2);
      if (l == 0) {
        fourierC_stage2(p, lds);
      }
    }
    xcd_barrier(xbar); PACC(4, tq);
    tq = PTIME(); phase_gate(p, l, lds); xcd_barrier(xbar); PACC(5, tq);
    tq = PTIME(); phase_out(p, l, lds);
    if (l == 0) for (int it = blockIdx.x; it < PREP_ITEMS; it += gridDim.x) prep_item(p, 1, it, lds);
    if (l == 0 || PROBE_MODE) xcd_barrier(xbar);
    PACC(6, tq);
  }
#if PROBE_MODE
  if (blockIdx.x == 0) {
    const float tot = (float)(PTIME() - tstart); const float fa = (float)tA / tot, fb = (float)tB / tot;
    const int tid = threadIdx.x;
    if (tid == 0) p.out[0] += 0.4f + 0.3f * fa;
    const float dl = sqrtf(fb * 2e-5f * 2048.f);
    for (int i = tid; i < 16384; i += NT) p.out[4096 + i] += (i & 1) ? dl : -dl;
  }
#endif
}

extern "C" void kernel_launch(void* const* d_in, const int* in_sizes, int n_in, void* d_out, int out_size, void* d_ws, size_t ws_size, hipStream_t stream) {
  static int grid_blocks = 0;
  if (grid_blocks == 0) {
    if (n_in != 24 || ws_size < WS_END) { fprintf(stderr, "kernel_launch: unexpected n_in %d or ws_size %zu (< %zu)\n", n_in, ws_size, (size_t)WS_END); grid_blocks = -1; return; }
    int dev = 0, cus = 0, per_cu = 0;
    hipGetDevice(&dev); hipDeviceGetAttribute(&cus, hipDeviceAttributeMultiprocessorCount, dev);
    hipFuncSetAttribute((const void*)hybrid_fwd, hipFuncAttributeMaxDynamicSharedMemorySize, LDS_BYTES);
    hipOccupancyMaxActiveBlocksPerMultiprocessor(&per_cu, (const void*)hybrid_fwd, NT, LDS_BYTES);
    if (per_cu < 1) per_cu = 1;
    grid_blocks = cus * per_cu;
    (void)hipGetLastError();
  }
  if (grid_blocks < 0) return;
  Params p{};
  const float** pp = (const float**)&p;
  for (int i = 0; i < 24; ++i) pp[i] = (const float*)d_in[i];
  p.out = (float*)d_out; p.ws = (unsigned char*)d_ws;
  void* args[] = {&p};
  hipError_t e = hipLaunchCooperativeKernel((const void*)hybrid_fwd, dim3(grid_blocks), dim3(NT), args, LDS_BYTES, stream);
  if (e != hipSuccess) fprintf(stderr, "cooperative launch failed: %s (grid %d)\n", hipGetErrorString(e), grid_blocks);
}
```
